# Optimizing an MI355X kernel written in HIP

```python
import math
import numpy as np
import jax
import jax.numpy as jnp
from jax import lax

D_MODEL = 1024
BATCH = 32
SEQ = 2048
DEPTH = 2

GRID_W = 64
CTX_LEN = 256
EPS = 1e-6
D_MIX = D_MODEL
W_POOL = D_MIX // 4
W_CONV = D_MIX // 4
W_NA = D_MIX // 4
W_SSD = D_MIX - W_POOL - W_CONV - W_NA
POOL_WINDOWS = (2, 4, 8, 16)
POOL_GROUP = W_POOL // len(POOL_WINDOWS)
CONV_K = 3
NA_HEADS = 4
NA_HEAD_DIM = W_NA // NA_HEADS
WIN_R = 8
WIN_C = 16
COL_BLOCK = 16
COL_BAND = 32
SSD_HEAD_DIM = 64
SSD_HEADS = W_SSD // SSD_HEAD_DIM
SSD_GROUPS = 2
SSD_STATE = 128
SSD_CONV_K = 3
SSD_CHUNK = 128
SSD_XBC = W_SSD + 2 * SSD_GROUPS * SSD_STATE
D_IN_PROJ = W_POOL + 3 * W_CONV + 3 * W_NA + W_SSD + SSD_XBC + 2 * SSD_HEADS
PROJ_SPLITS = (W_POOL, W_POOL + 3 * W_CONV, W_POOL + 3 * W_CONV + 3 * W_NA)
D_FF = 2816
N_EXPERTS = 8
TOP_K = 2
D_FF_EXPERT = 1408

kernel_name = 'hybrid_pool_conv_na_ssd_moe_dit'


def rmsnorm(x, g):
    xf = x.astype(jnp.float32)
    y = xf * lax.rsqrt(jnp.mean(xf * xf, axis=-1, keepdims=True) + EPS)
    return (y * g.astype(jnp.float32)).astype(x.dtype)


def dwconv_centered(u, w, b=None):
    k = w.shape[0]
    L = u.shape[1]
    p = k // 2
    up = jnp.pad(u, ((0, 0), (p, p), (0, 0)))
    y = up[:, 0:L] * w[0]
    for i in range(1, k):
        y = y + up[:, i:i + L] * w[i]
    return y if b is None else y + b


def pool_mix(u, w_grp, scale):
    bn, L, _ = u.shape
    s = jnp.pad(jnp.cumsum(u.astype(jnp.float32), axis=1), ((0, 0), (1, 0), (0, 0)))
    t = np.arange(L)
    outs = []
    for g, win in enumerate(POOL_WINDOWS):
        lo = np.clip(t - win // 2, 0, L)
        hi = np.clip(t - win // 2 + win, 0, L)
        sg = s[..., g * POOL_GROUP:(g + 1) * POOL_GROUP]
        cnt = jnp.asarray((hi - lo)[:, None], jnp.float32)
        mean = (sg[:, hi] - sg[:, lo]) / cnt
        outs.append(mean.astype(u.dtype) - u[..., g * POOL_GROUP:(g + 1) * POOL_GROUP])
    p = jnp.stack(outs, axis=2)
    y = jnp.einsum('blgc,gcd->blgd', p, w_grp).reshape(bn, L, W_POOL)
    return y * scale


def short_conv_mix(pr, w_conv):
    h, bg, cg = jnp.split(pr, 3, axis=-1)
    return bg * dwconv_centered(cg * h, w_conv)


def na_geometry():
    n_cb = GRID_W // COL_BLOCK
    c = np.arange(GRID_W).reshape(n_cb, COL_BLOCK)
    sc = np.clip(c - WIN_C // 2, 0, GRID_W - WIN_C)
    band0 = np.clip(np.arange(n_cb) * COL_BLOCK - WIN_C // 2, 0, GRID_W - COL_BAND)
    band_cols = band0[:, None] + np.arange(COL_BAND)
    kc = band_cols[:, None, :]
    col_mask = (kc >= sc[..., None]) & (kc < sc[..., None] + WIN_C)
    dc_idx = np.clip(kc - c[..., None] + WIN_C - 1, 0, 2 * WIN_C - 2)
    return band_cols, col_mask, dc_idx


def na_attention(q, k, v, k_ctx, v_ctx, rpb):
    bn, S, H, hd = q.shape
    rows = S // GRID_W
    kr = min(WIN_R, rows)
    band_cols, col_mask, dc_idx = na_geometry()
    n_cb = band_cols.shape[0]
    qg = q.reshape(bn, rows, n_cb, COL_BLOCK, H, hd)
    kg = k.reshape(bn, rows, GRID_W, H, hd)
    vg = v.reshape(bn, rows, GRID_W, H, hd)
    sm = 1.0 / math.sqrt(hd)
    mask = col_mask[:, :, None, :]

    def row_fn(r):
        sr = jnp.clip(r - kr // 2, 0, rows - kr)
        q_r = lax.dynamic_index_in_dim(qg, r, axis=1, keepdims=False)
        k_r = lax.dynamic_slice_in_dim(kg, sr, kr, axis=1)[:, :, band_cols]
        v_r = lax.dynamic_slice_in_dim(vg, sr, kr, axis=1)[:, :, band_cols]
        s_win = jnp.einsum('bjqhd,bijkhd->bhjqik', q_r, k_r).astype(jnp.float32) * sm
        ri = sr + jnp.arange(kr) - r + WIN_R - 1
        bias = jnp.take(rpb[:, ri], dc_idx, axis=2).transpose(0, 2, 3, 1, 4)
        s_win = jnp.where(mask, s_win + bias.astype(jnp.float32), -jnp.inf)
        s_win = s_win.reshape(bn, H, n_cb, COL_BLOCK, kr * COL_BAND)
        s_ctx = jnp.einsum('bjqhd,bkhd->bhjqk', q_r, k_ctx).astype(jnp.float32) * sm
        p = jax.nn.softmax(jnp.concatenate([s_win, s_ctx], axis=-1), axis=-1).astype(q.dtype)
        p_win = p[..., :kr * COL_BAND].reshape(bn, H, n_cb, COL_BLOCK, kr, COL_BAND)
        p_ctx = p[..., kr * COL_BAND:]
        return (jnp.einsum('bhjqik,bijkhd->bjqhd', p_win, v_r)
                + jnp.einsum('bhjqk,bkhd->bjqhd', p_ctx, v_ctx))

    o = lax.map(row_fn, jnp.arange(rows))
    return jnp.moveaxis(o, 0, 1).reshape(bn, S, H * hd)


def ctx_attention(q, k, v):
    bn, L, H, hd = q.shape
    s = jnp.einsum('bqhd,bkhd->bhqk', q, k).astype(jnp.float32) * (1.0 / math.sqrt(hd))
    p = jax.nn.softmax(s, axis=-1).astype(q.dtype)
    return jnp.einsum('bhqk,bkhd->bqhd', p, v).reshape(bn, L, H * hd)


def ssd_inputs(pr, conv_w, conv_b):
    bn, L, _ = pr.shape
    z, xbc, dt_raw = jnp.split(pr, [W_SSD, W_SSD + SSD_XBC], axis=-1)
    xbc = jax.nn.silu(dwconv_centered(xbc, conv_w, conv_b))
    xs, bs, cs = jnp.split(xbc, [W_SSD, W_SSD + SSD_GROUPS * SSD_STATE], axis=-1)
    xs = xs.reshape(bn, L, SSD_HEADS, SSD_HEAD_DIM)
    bs = bs.reshape(bn, L, SSD_GROUPS, SSD_STATE)
    cs = cs.reshape(bn, L, SSD_GROUPS, SSD_STATE)
    return z, xs, bs, cs, dt_raw


def ssd_chunked(x, dt, a, bmat, cmat, h0, need_y):
    bn, L, H, P = x.shape
    T = SSD_CHUNK
    nc = L // T
    f32 = jnp.float32
    rep = H // bmat.shape[2]
    bh = jnp.repeat(bmat.astype(f32), rep, axis=2).reshape(bn, nc, T, H, -1)
    ch = jnp.repeat(cmat.astype(f32), rep, axis=2).reshape(bn, nc, T, H, -1)
    xdt = (x.astype(f32) * dt[..., None]).reshape(bn, nc, T, H, P)
    la = (dt * a).reshape(bn, nc, T, H).transpose(0, 3, 1, 2)
    acum = jnp.cumsum(la, axis=-1)
    states = jnp.einsum('bclhn,bhcl,bclhp->bchpn', bh, jnp.exp(acum[..., -1:] - acum), xdt)
    states = jnp.concatenate([h0[:, None].astype(f32), states], axis=1)
    tot = jnp.pad(jnp.cumsum(acum[..., -1], axis=-1), ((0, 0), (0, 0), (1, 0)))
    tril_c = np.tril(np.ones((nc + 1, nc + 1), dtype=bool))
    decay_chunk = jnp.exp(jnp.where(tril_c, tot[..., :, None] - tot[..., None, :], -jnp.inf))
    states = jnp.einsum('bhzc,bchpn->bzhpn', decay_chunk, states)
    h_final = states[:, -1]
    if not need_y:
        return None, h_final
    tril_t = np.tril(np.ones((T, T), dtype=bool))
    lmat = jnp.exp(jnp.where(tril_t, acum[..., :, None] - acum[..., None, :], -jnp.inf))
    scores = jnp.einsum('bclhn,bcshn->bhcls', ch, bh) * lmat
    y = (jnp.einsum('bhcls,bcshp->bclhp', scores, xdt)
         + jnp.einsum('bclhn,bchpn,bhcl->bclhp', ch, states[:, :-1], jnp.exp(acum)))
    return y.reshape(bn, L, H, P), h_final


def rev(t, d):
    return t if d == 0 else jnp.flip(t, axis=1)


def ssd_mix(pr, pr_c, conv_w, conv_b, dt_bias, a_log, d_skip, norm_g, ctx_out):
    z, xs, bs, cs, dtr = ssd_inputs(pr, conv_w, conv_b)
    zc, xsc, bsc, csc, dtrc = ssd_inputs(pr_c, conv_w, conv_b)
    h0 = jnp.zeros((pr.shape[0], SSD_HEADS, SSD_HEAD_DIM, SSD_STATE), jnp.float32)
    y = xs.astype(jnp.float32) * d_skip.astype(jnp.float32)[:, None]
    yc = xsc.astype(jnp.float32) * d_skip.astype(jnp.float32)[:, None] if ctx_out else None
    for d in range(2):
        a = -jnp.exp(a_log[d].astype(jnp.float32))
        hs = slice(d * SSD_HEADS, (d + 1) * SSD_HEADS)
        dt_l = jax.nn.softplus(dtr[..., hs].astype(jnp.float32) + dt_bias[d].astype(jnp.float32))
        dt_c = jax.nn.softplus(dtrc[..., hs].astype(jnp.float32) + dt_bias[d].astype(jnp.float32))
        y_cd, h_c = ssd_chunked(rev(xsc, d), rev(dt_c, d), a, rev(bsc, d), rev(csc, d), h0, ctx_out)
        y_ld, _ = ssd_chunked(rev(xs, d), rev(dt_l, d), a, rev(bs, d), rev(cs, d), h_c, True)
        y = y + rev(y_ld, d)
        if ctx_out:
            yc = yc + rev(y_cd, d)
    o = rmsnorm(y.reshape(z.shape).astype(z.dtype) * jax.nn.silu(z), norm_g)
    if not ctx_out:
        return o, None
    oc = rmsnorm(yc.reshape(zc.shape).astype(zc.dtype) * jax.nn.silu(zc), norm_g)
    return o, oc


def mixer(pr, pr_c, pool_w, pool_scale, conv_w, rpb, s_conv_w, s_conv_b, dt_bias, a_log, d_skip,
          s_norm_g, ctx_out):
    bn, S, _ = pr.shape
    Lc = pr_c.shape[1]
    p_pool, p_conv, p_na, p_ssd = jnp.split(pr, PROJ_SPLITS, axis=-1)
    c_pool, c_conv, c_na, c_ssd = jnp.split(pr_c, PROJ_SPLITS, axis=-1)
    q, k, v = [t.reshape(bn, S, NA_HEADS, NA_HEAD_DIM) for t in jnp.split(p_na, 3, axis=-1)]
    qc, kc, vc = [t.reshape(bn, Lc, NA_HEADS, NA_HEAD_DIM) for t in jnp.split(c_na, 3, axis=-1)]
    o_ssd, oc_ssd = ssd_mix(p_ssd, c_ssd, s_conv_w, s_conv_b, dt_bias, a_log, d_skip, s_norm_g, ctx_out)
    o = jnp.concatenate([pool_mix(p_pool, pool_w, pool_scale),
                         short_conv_mix(p_conv, conv_w),
                         na_attention(q, k, v, kc, vc, rpb),
                         o_ssd], axis=-1)
    if not ctx_out:
        return o, None
    oc = jnp.concatenate([pool_mix(c_pool, pool_w, pool_scale),
                          short_conv_mix(c_conv, conv_w),
                          ctx_attention(qc, kc, vc),
                          oc_ssd], axis=-1)
    return o, oc


def swiglu(h, w_gu, w_down):
    g, u = jnp.split(h @ w_gu, 2, axis=-1)
    return (jax.nn.silu(g) * u) @ w_down


def moe_swiglu(h, w_router, w_gu, w_down):
    logits = (h @ w_router).astype(jnp.float32)
    top_v, top_i = lax.top_k(logits, TOP_K)
    gates = jax.nn.softmax(top_v, axis=-1)
    out = jnp.zeros_like(h)
    for e in range(N_EXPERTS):
        w_e = jnp.sum(jnp.where(top_i == e, gates, 0.0), axis=-1).astype(h.dtype)
        out = out + w_e[..., None] * swiglu(h, w_gu[e], w_down[e])
    return out


def setup_inputs(seed: int = 0) -> dict:
    key = jax.random.key(seed)
    keys = jax.random.split(key, 32)
    n_dense = (DEPTH + 1) // 2
    n_moe = DEPTH // 2

    def nrm(i, shape, s):
        return jax.random.normal(keys[i], shape, jnp.float32) * s

    dt0 = jnp.exp(jax.random.uniform(keys[17], (DEPTH, 2, SSD_HEADS), jnp.float32,
                                     minval=math.log(1e-3), maxval=math.log(1e-1)))
    return {
        'x': nrm(0, (BATCH, SEQ, D_MODEL), 1.0),
        'c': nrm(1, (BATCH, D_MODEL), 1.0),
        'ctx': nrm(2, (BATCH, CTX_LEN, D_MODEL), 1.0),
        'c_ctx': nrm(3, (D_MODEL,), 1.0),
        'w_ada': nrm(4, (DEPTH, D_MODEL, 6 * D_MODEL), D_MODEL ** -0.5),
        'b_ada': nrm(5, (DEPTH, 6 * D_MODEL), 0.02),
        'g_mix': 1.0 + nrm(6, (DEPTH, D_MODEL), 0.05),
        'g_ffn': 1.0 + nrm(7, (DEPTH, D_MODEL), 0.05),
        'w_in': nrm(8, (DEPTH, D_MODEL, D_IN_PROJ), D_MODEL ** -0.5),
        'w_out': nrm(9, (DEPTH, D_MIX, D_MODEL), D_MIX ** -0.5),
        'pool_w': nrm(10, (DEPTH, len(POOL_WINDOWS), POOL_GROUP, POOL_GROUP), POOL_GROUP ** -0.5),
        'pool_scale': 1.0 + nrm(11, (DEPTH, W_POOL), 0.1),
        'conv_w': nrm(12, (DEPTH, CONV_K, W_CONV), CONV_K ** -0.5),
        'na_rpb': nrm(13, (DEPTH, NA_HEADS, 2 * WIN_R - 1, 2 * WIN_C - 1), 0.1),
        'ssd_conv_w': nrm(14, (DEPTH, SSD_CONV_K, SSD_XBC), SSD_CONV_K ** -0.5),
        'ssd_conv_b': nrm(15, (DEPTH, SSD_XBC), 0.01),
        'ssd_dt_bias': dt0 + jnp.log(-jnp.expm1(-dt0)),
        'ssd_a_log': jnp.log(jax.random.uniform(keys[16], (DEPTH, 2, SSD_HEADS), jnp.float32,
                                                minval=1.0, maxval=16.0)),
        'ssd_d': 1.0 + nrm(18, (DEPTH, SSD_HEADS), 0.1),
        'ssd_norm_g': 1.0 + nrm(19, (DEPTH, W_SSD), 0.05),
        'ffn_w_gu': nrm(20, (n_dense, D_MODEL, 2 * D_FF), D_MODEL ** -0.5),
        'ffn_w_down': nrm(21, (n_dense, D_FF, D_MODEL), D_FF ** -0.5),
        'moe_router': nrm(22, (n_moe, D_MODEL, N_EXPERTS), D_MODEL ** -0.5),
        'moe_w_gu': nrm(23, (n_moe, N_EXPERTS, D_MODEL, 2 * D_FF_EXPERT), D_MODEL ** -0.5),
        'moe_w_down': nrm(24, (n_moe, N_EXPERTS, D_FF_EXPERT, D_MODEL), D_FF_EXPERT ** -0.5),
        'g_final': 1.0 + nrm(25, (D_MODEL,), 0.05),
    }


def reference(x, c, ctx, c_ctx, w_ada, b_ada, g_mix, g_ffn, w_in, w_out, pool_w, pool_scale, conv_w,
              na_rpb, ssd_conv_w, ssd_conv_b, ssd_dt_bias, ssd_a_log, ssd_d, ssd_norm_g, ffn_w_gu,
              ffn_w_down, moe_router, moe_w_gu, moe_w_down, g_final):
    s_c = jax.nn.silu(c)
    s_cc = jax.nn.silu(c_ctx)
    xc = ctx
    for l in range(DEPTH):
        ctx_out = l < DEPTH - 1
        sh1, sc1, gt1, sh2, sc2, gt2 = [m[:, None, :] for m in
                                        jnp.split(s_c @ w_ada[l] + b_ada[l], 6, axis=-1)]
        sh1c, sc1c, gt1c, sh2c, sc2c, gt2c = jnp.split(s_cc @ w_ada[l] + b_ada[l], 6, axis=-1)
        h = rmsnorm(x, g_mix[l]) * (1.0 + sc1) + sh1
        hc = rmsnorm(xc, g_mix[l]) * (1.0 + sc1c) + sh1c
        o, oc = mixer(h @ w_in[l], hc @ w_in[l], pool_w[l], pool_scale[l], conv_w[l], na_rpb[l],
                      ssd_conv_w[l], ssd_conv_b[l], ssd_dt_bias[l], ssd_a_log[l], ssd_d[l],
                      ssd_norm_g[l], ctx_out)
        x = x + gt1 * (o @ w_out[l])
        j = l // 2
        h = rmsnorm(x, g_ffn[l]) * (1.0 + sc2) + sh2
        if l % 2 == 0:
            x = x + gt2 * swiglu(h, ffn_w_gu[j], ffn_w_down[j])
        else:
            x = x + gt2 * moe_swiglu(h, moe_router[j], moe_w_gu[j], moe_w_down[j])
        if ctx_out:
            xc = xc + gt1c * (oc @ w_out[l])
            hc = rmsnorm(xc, g_ffn[l]) * (1.0 + sc2c) + sh2c
            if l % 2 == 0:
                xc = xc + gt2c * swiglu(hc, ffn_w_gu[j], ffn_w_down[j])
            else:
                xc = xc + gt2c * moe_swiglu(hc, moe_router[j], moe_w_gu[j], moe_w_down[j])
    return rmsnorm(x, g_final)
```

```cpp
#include <hip/hip_runtime.h>
#include <cstdio>
#include <cstdint>

#define LAS __attribute__((address_space(3)))
#define GAS __attribute__((address_space(1)))
typedef unsigned short bf16;
typedef short bf16x8 __attribute__((ext_vector_type(8)));
typedef float f32x4 __attribute__((ext_vector_type(4)));
typedef unsigned u32x4 __attribute__((ext_vector_type(4)));
typedef unsigned u32x2 __attribute__((ext_vector_type(2)));
typedef int i32x4 __attribute__((ext_vector_type(4)));
typedef int i32x8 __attribute__((ext_vector_type(8)));

constexpr int DM = 1024, NB = 32, SEQ = 2048, CTXL = 256, GRIDW = 64;
constexpr int ML = NB * SEQ;
constexpr int MC = NB * CTXL;
constexpr int MT = ML + MC;
constexpr int NPR = 2816;
constexpr int DIN = 2824;
constexpr int DFF = 2816, DFE = 1408, NEXP = 8;
constexpr int MOE_ROWS = 2 * ML + NEXP * 256;
constexpr float EPS = 1e-6f;
constexpr int C_POOL = 0, C_CONVH = 256, C_CONVB = 512, C_CONVC = 768, C_Q = 1024, C_K = 1280, C_V = 1536, C_Z = 1792, C_XBC = 2048;

constexpr size_t MiB = 1u << 20;
constexpr size_t WS_CTL = 0, CTL_BYTES = 1 * MiB;
constexpr size_t WS_MOD = 1 * MiB;
constexpr size_t WS_ROUTE = 3 * MiB;
constexpr size_t WS_ROWTOK = 5 * MiB;
constexpr size_t WS_WB = 8 * MiB;
constexpr size_t WS_XR = 106 * MiB;
constexpr size_t WS_HB = 394 * MiB;
constexpr size_t WS_PRB = 538 * MiB;
constexpr size_t WS_DT = 934 * MiB;
constexpr size_t WS_VT = 937 * MiB;
constexpr int VT_LD = 2304;
constexpr size_t WS_LISTE = 976 * MiB;
constexpr size_t WS_END = 1024 * MiB;
constexpr size_t WB_IN = 0, WB_IN_SZ = (size_t)NPR * DM * 2;
constexpr size_t WB_OUT = 2 * WB_IN_SZ, WB_OUT_SZ = (size_t)DM * DM * 2;
constexpr size_t WB_GU = WB_OUT + 2 * WB_OUT_SZ, WB_GU_SZ = (size_t)2 * DFF * DM * 2;
constexpr size_t WS_RS = WS_ROUTE;
constexpr size_t WS_CS = WS_ROWTOK;
constexpr size_t WS_CSIN = 6 * MiB;
constexpr size_t WB_DOWN = WB_GU + WB_GU_SZ, WB_DOWN_SZ = (size_t)DM * DFF * 2;
constexpr int DFEP = 1536;
constexpr float W8S = 32.f, H8S = 4.f;
constexpr size_t WB_MGU = WB_DOWN + WB_DOWN_SZ, WB_MGU_SZ = (size_t)2 * DFE * DM;
constexpr size_t WB_MDOWN = WB_MGU + NEXP * WB_MGU_SZ, WB_MDOWN_SZ = (size_t)DM * DFEP;
static_assert(WB_MDOWN + NEXP * WB_MDOWN_SZ <= 98 * MiB, "weights fit");
constexpr int CW_CNT = 512;
constexpr int CW_POFF = 128;
constexpr int CW_BAR = 4096;

constexpr int LDS_BYTES = 147456;
constexpr int LDSCTL_OFF = LDS_BYTES - 256;

__device__ __forceinline__ float bf2f(unsigned v) { return __uint_as_float(v << 16); }
__device__ __forceinline__ float bflo(unsigned w) { return __uint_as_float(w << 16); }
__device__ __forceinline__ float bfhi(unsigned w) { return __uint_as_float(w & 0xFFFF0000u); }
__device__ __forceinline__ unsigned pack2(float lo, float hi) { unsigned r; asm volatile("v_cvt_pk_bf16_f32 %0, %1, %2" : "=v"(r) : "v"(lo), "v"(hi)); return r; }
__device__ __forceinline__ bf16 f2bf(float f) { return (bf16)(pack2(f, 0.f) & 0xFFFFu); }
__device__ __forceinline__ unsigned pack4_fp8(float a, float b, float c, float d) {
    a = fminf(fmaxf(a, -448.f), 448.f); b = fminf(fmaxf(b, -448.f), 448.f); c = fminf(fmaxf(c, -448.f), 448.f); d = fminf(fmaxf(d, -448.f), 448.f);
    int w = 0; w = __builtin_amdgcn_cvt_pk_fp8_f32(a, b, w, false); w = __builtin_amdgcn_cvt_pk_fp8_f32(c, d, w, true); return (unsigned)w;
}
__device__ __forceinline__ float silu_f(float v) { return v * __builtin_amdgcn_rcpf(1.0f + __expf(-v)); }
__device__ __forceinline__ float softplus_f(float v) { return v > 20.f ? v : log1pf(__expf(v)); }
__device__ __forceinline__ float dpp_f(float v, const int ctrl_sel) {
    const int x = __float_as_int(v); int r;
    if (ctrl_sel == 0) r = __builtin_amdgcn_update_dpp(x, x, 0xB1, 0xF, 0xF, false);
    else if (ctrl_sel == 1) r = __builtin_amdgcn_update_dpp(x, x, 0x4E, 0xF, 0xF, false);
    else if (ctrl_sel == 2) r = __builtin_amdgcn_update_dpp(x, x, 0x141, 0xF, 0xF, false);
    else r = __builtin_amdgcn_update_dpp(x, x, 0x140, 0xF, 0xF, false);
    return __int_as_float(r);
}
__device__ __forceinline__ float row8_sum(float v) { v += dpp_f(v, 0); v += dpp_f(v, 1); v += dpp_f(v, 2); return v; }
__device__ __forceinline__ float wave_sum(float v) {
    v = row8_sum(v); v += dpp_f(v, 3);
    const float s0 = __int_as_float(__builtin_amdgcn_readlane(__float_as_int(v), 0)), s1 = __int_as_float(__builtin_amdgcn_readlane(__float_as_int(v), 16)),
                s2 = __int_as_float(__builtin_amdgcn_readlane(__float_as_int(v), 32)), s3 = __int_as_float(__builtin_amdgcn_readlane(__float_as_int(v), 48));
    return (s0 + s1) + (s2 + s3);
}
__device__ __forceinline__ float wave_scan_incl(float v, const int lane) {
#define WS_SHR(c) __int_as_float(__builtin_amdgcn_update_dpp(0, __float_as_int(v), (c), 0xF, 0xF, false))
    v += WS_SHR(0x111); v += WS_SHR(0x112); v += WS_SHR(0x114); v += WS_SHR(0x118);
#undef WS_SHR
    const float t0 = __int_as_float(__builtin_amdgcn_readlane(__float_as_int(v), 15)), t1 = __int_as_float(__builtin_amdgcn_readlane(__float_as_int(v), 31)), t2 = __int_as_float(__builtin_amdgcn_readlane(__float_as_int(v), 47));
    return v + ((lane >= 16 ? t0 : 0.f) + (lane >= 32 ? t1 : 0.f)) + (lane >= 48 ? t2 : 0.f);
}
__device__ __forceinline__ float wave_max_dpp(float v) {
    v = fmaxf(v, dpp_f(v, 0)); v = fmaxf(v, dpp_f(v, 1)); v = fmaxf(v, dpp_f(v, 2)); v = fmaxf(v, dpp_f(v, 3));
    const float s0 = __int_as_float(__builtin_amdgcn_readlane(__float_as_int(v), 0)), s1 = __int_as_float(__builtin_amdgcn_readlane(__float_as_int(v), 16)),
                s2 = __int_as_float(__builtin_amdgcn_readlane(__float_as_int(v), 32)), s3 = __int_as_float(__builtin_amdgcn_readlane(__float_as_int(v), 48));
    return fmaxf(fmaxf(s0, s1), fmaxf(s2, s3));
}
__device__ __forceinline__ unsigned pack4_i8(float a, float b, float c, float d) {
    const int ia = __float2int_rn(a), ib = __float2int_rn(b), ic = __float2int_rn(c), id = __float2int_rn(d);
    return (unsigned)(ia & 255) | ((unsigned)(ib & 255) << 8) | ((unsigned)(ic & 255) << 16) | ((unsigned)(id & 255) << 24);
}
__device__ __forceinline__ float wave_max(float v) {
#pragma unroll
    for (int o = 32; o >= 1; o >>= 1) v = fmaxf(v, __shfl_xor(v, o));
    return v;
}
__device__ __forceinline__ int lane_id_fresh() { int l; asm volatile("v_mbcnt_lo_u32_b32 %0, -1, 0\n\tv_mbcnt_hi_u32_b32 %0, -1, %0" : "=v"(l)); return l; }
__device__ __forceinline__ int modidx_of(int m) { return m < ML ? (m >> 11) : 32; }

#define XB_TMO      128
#define XB_XCNT(j)  (256  + 64 * (j))
#define XB_XSUB(j)  (1280 + 64 * (j))
#define XB_XGEN(j)  (2304 + 64 * (j))
#define XB_TOP      3328
#define XB_TOPGEN   3392
#define XCD_BAR_WORDS 3456
#define XB_SPIN_CAP (1u << 22)
__device__ __forceinline__ unsigned xb_ld(unsigned* p)              { return __hip_atomic_load(p, __ATOMIC_RELAXED, __HIP_MEMORY_SCOPE_AGENT); }
__device__ __forceinline__ unsigned xb_add(unsigned* p, unsigned v) { return __hip_atomic_fetch_add(p, v, __ATOMIC_RELAXED, __HIP_MEMORY_SCOPE_AGENT); }
__device__ __forceinline__ unsigned xb_xcc_id() { return (unsigned)__builtin_amdgcn_s_getreg((3 << 11) | 20) & 0xFu; }
#define XB_SPIN(cond, bar) do { unsigned _sp = 0; while (cond) { __builtin_amdgcn_s_sleep(1); \
    if ((++_sp & 255u) == 0u) { if (xb_ld(&(bar)[XB_TMO])) break; if (_sp > XB_SPIN_CAP) { atomicAdd(&(bar)[XB_TMO], 1u); break; } } } } while (0)
struct XcdBarrier { unsigned* bar; unsigned x; volatile LAS unsigned* st; };
__device__ __forceinline__ XcdBarrier xcd_barrier_post(unsigned* bar, volatile LAS unsigned* st) {
    XcdBarrier b; b.bar = bar; b.x = xb_xcc_id(); b.st = st;
    if (threadIdx.x == 0) (void)xb_add(&bar[XB_XCNT(b.x)], 1u);
    return b;
}
__device__ __forceinline__ void xcd_barrier_complete(unsigned* bar, unsigned x, unsigned& nloc, unsigned& nx) {
    const unsigned G = gridDim.x * gridDim.y * gridDim.z;
    unsigned sum, cnt, mine, sp = 0u;
    for (;;) {
        sum = 0u; cnt = 0u; mine = 0u;
#pragma unroll
        for (unsigned j = 0; j < 16; ++j) { const unsigned c = xb_ld(&bar[XB_XCNT(j)]); sum += c; cnt += (c > 0u) ? 1u : 0u; mine = (j == x) ? c : mine; }
        if (sum == G) break;
        __builtin_amdgcn_s_sleep(1);
        if ((++sp & 255u) == 0u) { if (xb_ld(&bar[XB_TMO])) break; if (sp > XB_SPIN_CAP) { atomicAdd(&bar[XB_TMO], 1u); break; } }
    }
    nloc = mine > 0u ? mine : 1u; nx = cnt > 0u ? cnt : 1u;
}
__device__ __forceinline__ void xcd_barrier(const XcdBarrier& b, const int wv) {
    asm volatile("s_waitcnt vmcnt(0)" ::: "memory");
    __syncthreads();
    if (wv == 0 && lane_id_fresh() == 0) {
        unsigned* bar = b.bar;
        __builtin_amdgcn_s_waitcnt(0);
        unsigned nloc = b.st[0], nx = b.st[1];
        if (nloc == 0u) { xcd_barrier_complete(bar, b.x, nloc, nx); b.st[0] = nloc; b.st[1] = nx; }
        const unsigned old = xb_add(&bar[XB_XSUB(b.x)], 1u);
        const unsigned gen = old / nloc;
        if (old + 1u == (gen + 1u) * nloc) {
            __builtin_amdgcn_fence(__ATOMIC_RELEASE, "agent");
            asm volatile("s_waitcnt vmcnt(0)" ::: "memory");
            const unsigned og = xb_add(&bar[XB_TOP], 1u);
            const unsigned tg = og / nx;
            if (og + 1u == (tg + 1u) * nx) xb_add(&bar[XB_TOPGEN], 1u);
            else XB_SPIN(xb_ld(&bar[XB_TOPGEN]) == tg, bar);
            __builtin_amdgcn_fence(__ATOMIC_ACQUIRE, "agent");
            xb_add(&bar[XB_XGEN(b.x)], 1u);
            asm volatile("s_waitcnt vmcnt(0)" ::: "memory");
        } else {
            XB_SPIN(xb_ld(&bar[XB_XGEN(b.x)]) == gen, bar);
            __builtin_amdgcn_fence(__ATOMIC_ACQUIRE, "agent");
            asm volatile("s_waitcnt vmcnt(0)" ::: "memory");
        }
    }
    __syncthreads();
}

namespace pg8 {
constexpr int BM = 256, BK = 64, HALF = 128, HTB = HALF * BK * 2, STAGE_BYTES = 8 * HTB, NXCD = 8, WGM = 8;
__host__ __device__ __forceinline__ int lds_byte(int r, int c) { const int st = (r >> 4) * 2 + (c >> 5), rr = r & 15, cc = c & 31, ob = rr * 64 + cc * 2; return st * 1024 + (ob ^ (((ob >> 9) & 1) << 5)); }
__host__ __device__ __forceinline__ void stage_rc(int b, int& R, int& C) { const int st = b / 1024, sb = b % 1024, swz = sb ^ (((sb >> 9) & 1) << 5); R = (st >> 1) * 16 + swz / 64; C = (st & 1) * 32 + (swz % 64) / 2; }
__host__ __device__ __forceinline__ int perm32(int rho) { const int n = rho >> 4, i = rho & 15; return 8 * (i >> 2) + 4 * n + (i & 3); }

struct Unit { int pm, pn, ex, ploc; };

__device__ __forceinline__ unsigned magic_of(unsigned d) { return (unsigned)((0x100000000ull + d - 1) / d); }
__device__ __forceinline__ int div_magic(int x, unsigned mg) { return (int)__umulhi((unsigned)x, mg); }
template <bool LIN> struct DenseOrderT {
    static constexpr bool LINEAR = LIN;
    static constexpr bool GATHER = LIN;
    int nM, nN, nwg, G, c; unsigned mg_nig;
    __device__ void init(int M, int N, int G_, int c_) { nM = M / BM; nN = N / BM; nwg = nM * nN; G = G_; c = c_; mg_nig = __builtin_amdgcn_readfirstlane(magic_of((unsigned)(WGM * nN))); }
    __device__ bool next(int i, Unit& u) const {
        const long L = (long)i * G + c; if (L >= nwg) return false;
        int wgid = (int)L; { const int q = nwg / NXCD, r = nwg % NXCD, xcd = wgid % NXCD, off = wgid / NXCD; wgid = (xcd < r ? xcd * (q + 1) : r * (q + 1) + (xcd - r) * q) + off; }
        const int nig = WGM * nN, gid = div_magic(wgid, mg_nig), rem = wgid - gid * nig, fm = gid * WGM, gsz = (nM - fm) < WGM ? (nM - fm) : WGM;
        int pn;
        if (gsz == WGM) pn = rem / WGM;
        else { const unsigned mg = gsz == 1 ? 65536u : gsz == 2 ? 32768u : gsz == 3 ? 21846u : gsz == 4 ? 16384u : gsz == 5 ? 13108u : gsz == 6 ? 10923u : 9363u; pn = (int)(((unsigned)rem * mg) >> 16); }
        u.pm = fm + (rem - pn * gsz); u.pn = pn; u.ex = 0; u.ploc = 0; return true;
    }
    __device__ __forceinline__ size_t bexp(const Unit&) const { return 0; }
    __device__ __forceinline__ int arow(const Unit& u, int r) const { return u.pm * BM + r; }
};
using DenseOrder = DenseOrderT<false>;
template <bool LIN> struct InProjL1OrderT {
    static constexpr bool GATHER = LIN, LINEAR = LIN;
    DenseOrder D; int G, c, nlat;
    __device__ void init(int G_, int c_) { D.init(ML, NPR, G_, 0); G = G_; c = c_; nlat = (ML / BM) * (NPR / BM); }
    __device__ bool next(int i, Unit& u) const {
        const int L = i * G + c;
        if (L < nlat) { DenseOrder T = D; T.c = c; return T.next(i, u); }
        const int q = L - nlat; if (q >= (MC / BM) * 5) return false;
        const int t = q % 5; u.pm = ML / BM + q / 5; u.pn = (t == 0) ? 5 : (t == 1) ? 6 : 5 + t + 1; u.ex = 0; u.ploc = 0; return true;
    }
    __device__ __forceinline__ size_t bexp(const Unit&) const { return 0; }
    __device__ __forceinline__ int arow(const Unit& u, int r) const { return u.pm * BM + r; }
};
using InProjL1Order = InProjL1OrderT<false>;
template <bool GATHER_, bool LINEAR_ = false> struct MoeOrder {
    static constexpr bool GATHER = GATHER_ || LINEAR_, LINEAR = LINEAR_;
    const int* rowtok;
    size_t bstride;
    int nN, G, c, npan; int pf[7]; unsigned mg_nN;
    __device__ void init(const unsigned* cnt_, const int* rowtok_, size_t bstride_, int N, int G_, int c_) { rowtok = rowtok_; bstride = bstride_; nN = N / BM; G = G_; c = c_;
        int acc = 0;
#pragma unroll
        for (int j = 0; j < NEXP; ++j) { const int cj = __builtin_amdgcn_readfirstlane((int)cnt_[j * 64]); acc += (cj + BM - 1) / BM; if (j < 7) pf[j] = acc; }
        npan = acc;
        mg_nN = __builtin_amdgcn_readfirstlane(magic_of((unsigned)nN)); }
    __device__ bool next(int i, Unit& u) const {
        const long L = (long)i * G + c; const int U = npan * nN; if (L >= U) return false;
        int wgid = (int)L; { const int q = U / NXCD, r = U % NXCD, xcd = wgid % NXCD, off = wgid / NXCD; wgid = (xcd < r ? xcd * (q + 1) : r * (q + 1) + (xcd - r) * q) + off; }
        u.pm = div_magic(wgid, mg_nN); u.pn = wgid - u.pm * nN;
        int e = 0, pb = 0;
#pragma unroll
        for (int j = 0; j < 7; ++j) if (u.pm >= pf[j]) { e = j + 1; pb = pf[j]; }
        u.ex = e; u.ploc = u.pm - pb; return true;
    }
    __device__ __forceinline__ size_t bexp(const Unit& u) const { return (size_t)u.ex * bstride; }
    __device__ __forceinline__ int arow(const Unit& u, int r) const { if (LINEAR_) return u.pm * BM + r; const int ts = rowtok[u.ex * 65536 + u.ploc * BM + r]; return ts < 0 ? 0 : (ts >> 1); }
};

template <class Epi, class Sched, int QM = 0>
__device__ __forceinline__ void gemm_phase(LAS unsigned char* lds, const int wv, const bf16* Aptr, const bf16* Btptr, const int K, const Sched& S, const Epi& E) {
    constexpr bool GATHER = Sched::GATHER, LINEAR = Sched::LINEAR; constexpr bool F8 = (QM == 1), I8 = (QM == 2);
    const int lane = lane_id_fresh(), wid = wv, tid = wid * 64 + lane, wr = wid >> 2, wc = wid & 3, fr = lane & 15, fq = lane >> 4;
    const int nt = K / BK;
    unsigned voffA[2], voffB[2];
#pragma unroll
    for (int i = 0; i < 2; ++i) { int R, C; stage_rc(tid * 16 + i * 8192, R, C); const int Rb = Epi::PERM ? ((R & ~31) + perm32(R & 31)) : R;
        voffA[i] = (unsigned)(R * K + C) * 2u; voffB[i] = (unsigned)(Rb * K + C) * 2u; }
    const size_t kstep = (size_t)(BK * 2);
    const size_t hstep = (size_t)HALF * K * 2;
    const size_t tstep = 2 * hstep;
    const unsigned ldsw = (unsigned)wid * 1024u;
    const int aoff = lds_byte(wr * 64 + fr, fq * 8), boff = lds_byte(wc * 32 + fr, fq * 8);
#define PG8_SA(b, h) (((b) * 2 + (h)) * HTB)
#define PG8_SB(b, h) ((4 + (b) * 2 + (h)) * HTB)
#define PG8_STAGE(bufoff, gbase, voff) do { _Pragma("unroll") for (int _i = 0; _i < 2; ++_i) \
        __builtin_amdgcn_global_load_lds((const unsigned*)((const char*)(gbase) + (voff)[_i]), (LAS unsigned*)(lds + (bufoff) + ldsw + _i * 8192), 16, 0, 0); } while (0)
#define PG8_LDA(dst, b, h) do { if constexpr (F8) { _Pragma("unroll") for (int m = 0; m < 4; ++m) dst##8[m] = __builtin_shufflevector(*(const LAS i32x4*)(lds + PG8_SA(b, h) + aoff + m * 2048), *(const LAS i32x4*)(lds + PG8_SA(b, h) + aoff + m * 2048 + 1024), 0, 1, 2, 3, 4, 5, 6, 7); } \
        else { _Pragma("unroll") for (int m = 0; m < 4; ++m) _Pragma("unroll") for (int k = 0; k < 2; ++k) dst[m][k] = *(const LAS bf16x8*)(lds + PG8_SA(b, h) + aoff + m * 2048 + k * 1024); } } while (0)
#define PG8_LDB(dst, b, h) do { if constexpr (F8) { _Pragma("unroll") for (int n = 0; n < 2; ++n) dst##8[n] = __builtin_shufflevector(*(const LAS i32x4*)(lds + PG8_SB(b, h) + boff + n * 2048), *(const LAS i32x4*)(lds + PG8_SB(b, h) + boff + n * 2048 + 1024), 0, 1, 2, 3, 4, 5, 6, 7); } \
        else { _Pragma("unroll") for (int n = 0; n < 2; ++n) _Pragma("unroll") for (int k = 0; k < 2; ++k) dst[n][k] = *(const LAS bf16x8*)(lds + PG8_SB(b, h) + boff + n * 2048 + k * 1024); } } while (0)
#define PG8_MMA(ai, bj, At, Bt) do { __builtin_amdgcn_s_setprio(1); \
        if constexpr (F8) { _Pragma("unroll") for (int m = 0; m < 4; ++m) _Pragma("unroll") for (int n = 0; n < 2; ++n) \
            acc[ai][bj][m][n] = __builtin_amdgcn_mfma_scale_f32_16x16x128_f8f6f4(Bt##8[n], At##8[m], acc[ai][bj][m][n], 0, 0, 0, 0x7F7F7F7F, 0, 0x7F7F7F7F); } \
        else if constexpr (I8) { _Pragma("unroll") for (int m = 0; m < 4; ++m) _Pragma("unroll") for (int n = 0; n < 2; ++n) _Pragma("unroll") for (int k = 0; k < 2; ++k) \
            acc[ai][bj][m][n] = __builtin_bit_cast(f32x4, __builtin_amdgcn_mfma_i32_16x16x64_i8(__builtin_bit_cast(i32x4, Bt[n][k]), __builtin_bit_cast(i32x4, At[m][k]), __builtin_bit_cast(i32x4, acc[ai][bj][m][n]), 0, 0, 0)); } \
        else { _Pragma("unroll") for (int m = 0; m < 4; ++m) _Pragma("unroll") for (int n = 0; n < 2; ++n) _Pragma("unroll") for (int k = 0; k < 2; ++k) \
            acc[ai][bj][m][n] = __builtin_amdgcn_mfma_f32_16x16x32_bf16(Bt[n][k], At[m][k], acc[ai][bj][m][n], 0, 0, 0); } \
        __builtin_amdgcn_s_setprio(0); } while (0)
#define PG8_WAIT_V(n) asm volatile("s_waitcnt vmcnt(" #n ")" ::: "memory")
#define PG8_WAIT_L(n) asm volatile("s_waitcnt lgkmcnt(" #n ")" ::: "memory")
#define PG8_BAR __builtin_amdgcn_s_barrier()
#define PG8_SCHED __builtin_amdgcn_sched_barrier(0)
    Unit cur, nxt; int ui = 0;
    if (!S.next(0, cur)) return;
    f32x4 acc[2][2][4][2];
#pragma unroll
    for (int a = 0; a < 2; ++a)
#pragma unroll
        for (int b = 0; b < 2; ++b)
#pragma unroll
            for (int m = 0; m < 4; ++m)
#pragma unroll
                for (int n = 0; n < 2; ++n) acc[a][b][m][n] = (f32x4){0.f, 0.f, 0.f, 0.f};
    bf16x8 At[4][2], B0[2][2], B1[2][2];
    i32x8 At8[4], B08[2], B18[2];
    unsigned gAc0[2], gAc1[2];
    LAS u32x4* gslot = (LAS u32x4*)(lds + STAGE_BYTES) + tid;
    if constexpr (GATHER) {
#pragma unroll
        for (int i = 0; i < 2; ++i) { int R, C; stage_rc(tid * 16 + i * 8192, R, C); gAc0[i] = (unsigned)(S.arow(cur, R) * K + C) * 2u; gAc1[i] = (unsigned)(S.arow(cur, HALF + R) * K + C) * 2u; }
    }
    const char* cA = GATHER ? (const char*)Aptr : (const char*)Aptr + (size_t)cur.pm * tstep;
    const char* cB = (const char*)Btptr + S.bexp(cur) + (size_t)cur.pn * tstep;
#define PG8_STAGE_A(bufoff, kbase, half, usenext) do { if constexpr (GATHER) { if (half) PG8_STAGE(bufoff, kbase, gAc1); else PG8_STAGE(bufoff, kbase, gAc0); } \
        else { PG8_STAGE(bufoff, (kbase) + ((half) ? hstep : 0), voffA); } } while (0)
    PG8_STAGE(PG8_SB(0, 0), cB, voffB); PG8_STAGE(PG8_SB(0, 1), cB + hstep, voffB); PG8_STAGE_A(PG8_SA(0, 0), cA, 0, false); PG8_STAGE_A(PG8_SA(0, 1), cA, 1, false);
    if (wr == 1) PG8_BAR;
    PG8_WAIT_V(2); PG8_BAR;
    PG8_STAGE(PG8_SB(1, 0), cB + kstep, voffB); PG8_STAGE_A(PG8_SA(1, 0), cA + kstep, 0, false); PG8_STAGE(PG8_SB(1, 1), cB + hstep + kstep, voffB);
    PG8_WAIT_V(6); PG8_BAR;
    for (;;) {
        const bool has_next = S.next(ui + 1, nxt);
        const char* nA = GATHER ? (const char*)Aptr : (has_next ? (const char*)Aptr + (size_t)nxt.pm * tstep : cA);
        const char* nB = has_next ? (const char*)Btptr + S.bexp(nxt) + (size_t)nxt.pn * tstep : cB;
        const unsigned lin_dlt = (LINEAR && has_next) ? (unsigned)((nxt.pm - cur.pm) * (int)tstep) : 0u;
        if constexpr (GATHER && !LINEAR) {
            u32x4 gn;
            if (has_next) { int R, C; stage_rc(tid * 16, R, C); gn.x = (unsigned)(S.arow(nxt, R) * K + C) * 2u; gn.z = (unsigned)(S.arow(nxt, HALF + R) * K + C) * 2u;
                stage_rc(tid * 16 + 8192, R, C); gn.y = (unsigned)(S.arow(nxt, R) * K + C) * 2u; gn.w = (unsigned)(S.arow(nxt, HALF + R) * K + C) * 2u; }
            else { gn.x = gAc0[0]; gn.y = gAc0[1]; gn.z = gAc1[0]; gn.w = gAc1[1]; }
            asm volatile("ds_write_b128 %0, %1" :: "v"((unsigned)(size_t)gslot), "v"(gn) : "memory");
        }
#pragma nounroll
        for (int t = 0; t < nt; t += 2) {
            const bool last = (t == nt - 2);
            const char* a1 = cA + (size_t)(t + 1) * kstep;
            const char* a2 = last ? nA : cA + (size_t)(t + 2) * kstep; const char* b2 = last ? nB : cB + (size_t)(t + 2) * kstep;
            const char* a3 = a2 + kstep; const char* b3 = b2 + kstep;
            PG8_LDB(B0, 0, 0); PG8_LDB(B1, 0, 1); PG8_SCHED; PG8_LDA(At, 0, 0); PG8_STAGE_A(PG8_SA(1, 1), a1, 1, false);
            if constexpr (GATHER) { if (last) {
                if constexpr (LINEAR) { gAc0[0] += lin_dlt; gAc0[1] += lin_dlt; gAc1[0] += lin_dlt; gAc1[1] += lin_dlt; }
                else { u32x4 gn; asm volatile("ds_read_b128 %0, %1\n\ts_waitcnt lgkmcnt(0)" : "=v"(gn) : "v"((unsigned)(size_t)gslot) : "memory"); gAc0[0] = gn.x; gAc0[1] = gn.y; gAc1[0] = gn.z; gAc1[1] = gn.w; } } }
            PG8_WAIT_V(8); PG8_WAIT_L(0); PG8_BAR; PG8_MMA(0, 0, At, B0); PG8_MMA(0, 1, At, B1); PG8_BAR; PG8_SCHED;
            PG8_LDA(At, 0, 1); PG8_STAGE(PG8_SB(0, 0), b2, voffB); PG8_STAGE(PG8_SB(0, 1), b2 + hstep, voffB); PG8_STAGE_A(PG8_SA(0, 0), a2, 0, last);
            PG8_WAIT_V(8); PG8_WAIT_L(0); PG8_BAR; PG8_MMA(1, 0, At, B0); PG8_MMA(1, 1, At, B1); PG8_BAR; PG8_SCHED;
            PG8_LDB(B0, 1, 0); PG8_LDB(B1, 1, 1); PG8_SCHED; PG8_LDA(At, 1, 0); PG8_STAGE_A(PG8_SA(0, 1), a2, 1, last);
            PG8_WAIT_V(8); PG8_WAIT_L(0); PG8_BAR; PG8_MMA(0, 0, At, B0); PG8_MMA(0, 1, At, B1); PG8_BAR; PG8_SCHED;
            PG8_LDA(At, 1, 1); PG8_STAGE(PG8_SB(1, 0), b3, voffB); PG8_STAGE(PG8_SB(1, 1), b3 + hstep, voffB); PG8_STAGE_A(PG8_SA(1, 0), a3, 0, last);
            PG8_WAIT_V(8); PG8_WAIT_L(0); PG8_BAR; PG8_MMA(1, 0, At, B0); PG8_MMA(1, 1, At, B1); PG8_BAR; PG8_SCHED;
        }
        if (wr == 0) PG8_BAR;
        if constexpr (I8) { const int ln_ = lane_id_fresh(); E(acc, cur, wr, wc, ln_ & 15, ln_ >> 4); }
        else E(acc, cur, wr, wc, fr, fq);
        if (!has_next) break;
#pragma unroll
        for (int a = 0; a < 2; ++a)
#pragma unroll
            for (int b = 0; b < 2; ++b)
#pragma unroll
                for (int m = 0; m < 4; ++m)
#pragma unroll
                    for (int n = 0; n < 2; ++n) acc[a][b][m][n] = (f32x4){0.f, 0.f, 0.f, 0.f};
        cur = nxt; cA = nA; cB = nB; ++ui;
        if (wr == 1) PG8_BAR;
    }
    PG8_WAIT_V(0);
    PG8_BAR;
#undef PG8_SA
#undef PG8_SB
#undef PG8_STAGE
#undef PG8_STAGE_A
#undef PG8_LDA
#undef PG8_LDB
#undef PG8_MMA
#undef PG8_WAIT_V
#undef PG8_WAIT_L
#undef PG8_BAR
#undef PG8_SCHED
}

struct EpiBf16Plain {
    static constexpr bool PERM = true;
    bf16* O; int ldc;
    __device__ __forceinline__ void operator()(const f32x4 (&acc)[2][2][4][2], const Unit& u, int wr, int wc, int fr, int fq) const {
        const int row0 = u.pm * BM + wr * 64 + fr, col0 = u.pn * BM + wc * 32 + 8 * fq;
#pragma unroll
        for (int ai = 0; ai < 2; ++ai)
#pragma unroll
            for (int m = 0; m < 4; ++m) { bf16* rowp = O + (size_t)(row0 + ai * HALF + m * 16) * ldc + col0;
#pragma unroll
                for (int bj = 0; bj < 2; ++bj) { const f32x4 v0 = acc[ai][bj][m][0], v1 = acc[ai][bj][m][1];
                    u32x4 w; w.x = pack2(v0[0], v0[1]); w.y = pack2(v0[2], v0[3]); w.z = pack2(v1[0], v1[1]); w.w = pack2(v1[2], v1[3]);
                    *(u32x4*)(rowp + bj * HALF) = w; } }
    }
};
template <bool SRC_F32> struct EpiResid {
    static constexpr bool PERM = true;
    bf16* XR; const float* xlat; const float* xctx; const float* gate;
    __device__ __forceinline__ void operator()(const f32x4 (&acc)[2][2][4][2], const Unit& u, int wr, int wc, int fr, int fq) const {
        const int m0 = u.pm * BM, row0 = m0 + wr * 64 + fr, col0 = u.pn * BM + wc * 32 + 8 * fq;
        const float* gp = gate + (size_t)(m0 < ML ? (m0 >> 11) : 32) * 6144 + col0;
        f32x4 g[2][2];
        bf16* xr = XR + (size_t)row0 * DM + col0;
#define EPR_GATE _Pragma("unroll") for (int bj = 0; bj < 2; ++bj) _Pragma("unroll") for (int n = 0; n < 2; ++n) g[bj][n] = *(const f32x4*)(gp + bj * HALF + 4 * n);
        if constexpr (!SRC_F32) {
            u32x4 sv[2][4][2];
#pragma unroll
            for (int ai = 0; ai < 2; ++ai)
#pragma unroll
                for (int m = 0; m < 4; ++m)
#pragma unroll
                    for (int bj = 0; bj < 2; ++bj) sv[ai][m][bj] = *(const u32x4*)(xr + (size_t)(ai * HALF + m * 16) * DM + bj * HALF);
            EPR_GATE
            __builtin_amdgcn_sched_barrier(0);
#pragma unroll
            for (int ai = 0; ai < 2; ++ai)
#pragma unroll
                for (int m = 0; m < 4; ++m)
#pragma unroll
                    for (int bj = 0; bj < 2; ++bj) { const u32x4 x = sv[ai][m][bj]; const f32x4 v0 = acc[ai][bj][m][0] * g[bj][0], v1 = acc[ai][bj][m][1] * g[bj][1];
                        u32x4 w; w.x = pack2(bflo(x.x) + v0[0], bfhi(x.x) + v0[1]); w.y = pack2(bflo(x.y) + v0[2], bfhi(x.y) + v0[3]); w.z = pack2(bflo(x.z) + v1[0], bfhi(x.z) + v1[1]); w.w = pack2(bflo(x.w) + v1[2], bfhi(x.w) + v1[3]);
                        *(u32x4*)(xr + (size_t)(ai * HALF + m * 16) * DM + bj * HALF) = w; }
        } else {
            const float* sp = (m0 < ML ? xlat + (size_t)row0 * DM : xctx + (size_t)(row0 - ML) * DM) + col0;
#pragma unroll
            for (int ai = 0; ai < 2; ++ai) {
                f32x4 sf[4][2][2];
#pragma unroll
                for (int m = 0; m < 4; ++m)
#pragma unroll
                    for (int bj = 0; bj < 2; ++bj)
#pragma unroll
                        for (int n = 0; n < 2; ++n) sf[m][bj][n] = *(const f32x4*)(sp + (size_t)(ai * HALF + m * 16) * DM + bj * HALF + 4 * n);
                if (ai == 0) { EPR_GATE }
                __builtin_amdgcn_sched_barrier(0);
#pragma unroll
                for (int m = 0; m < 4; ++m)
#pragma unroll
                    for (int bj = 0; bj < 2; ++bj) { const f32x4 v0 = sf[m][bj][0] + acc[ai][bj][m][0] * g[bj][0], v1 = sf[m][bj][1] + acc[ai][bj][m][1] * g[bj][1];
                        u32x4 w; w.x = pack2(v0[0], v0[1]); w.y = pack2(v0[2], v0[3]); w.z = pack2(v1[0], v1[1]); w.w = pack2(v1[2], v1[3]);
                        *(u32x4*)(xr + (size_t)(ai * HALF + m * 16) * DM + bj * HALF) = w; }
                __builtin_amdgcn_sched_barrier(0);
            }
        }
#undef EPR_GATE
    }
};
struct EpiInProj {
    static constexpr bool PERM = true;
    bf16* O; bf16* VT;
    __device__ __forceinline__ void operator()(const f32x4 (&acc)[2][2][4][2], const Unit& u, int wr, int wc, int fr, int fq) const {
        if (u.pn == 6) {
            const int m0 = u.pm * BM; int b, tb;
            if (m0 < ML) { b = m0 >> 11; tb = 256 + (m0 - (b << 11)); } else { b = (m0 - ML) >> 8; tb = 0; }
            bf16* vb = VT + (size_t)b * 256 * VT_LD + tb + wr * 64 + fr;
            const int c0 = wc * 32 + 8 * fq;
#pragma unroll
            for (int ai = 0; ai < 2; ++ai)
#pragma unroll
                for (int m = 0; m < 4; ++m)
#pragma unroll
                    for (int bj = 0; bj < 2; ++bj)
#pragma unroll
                        for (int n = 0; n < 2; ++n)
#pragma unroll
                            for (int e = 0; e < 4; ++e) vb[(size_t)(c0 + bj * HALF + 4 * n + e) * VT_LD + ai * HALF + m * 16] = f2bf(acc[ai][bj][m][n][e]);
            return;
        }
        const int row0 = u.pm * BM + wr * 64 + fr, col0 = u.pn * BM + wc * 32 + 8 * fq;
#pragma unroll
        for (int ai = 0; ai < 2; ++ai)
#pragma unroll
            for (int m = 0; m < 4; ++m) { bf16* rowp = O + (size_t)(row0 + ai * HALF + m * 16) * NPR + col0;
#pragma unroll
                for (int bj = 0; bj < 2; ++bj) { const f32x4 v0 = acc[ai][bj][m][0], v1 = acc[ai][bj][m][1];
                    u32x4 w; w.x = pack2(v0[0], v0[1]); w.y = pack2(v0[2], v0[3]); w.z = pack2(v1[0], v1[1]); w.w = pack2(v1[2], v1[3]);
                    *(u32x4*)(rowp + bj * HALF) = w; } }
    }
};
struct EpiInProjI8 {
    static constexpr bool PERM = true;
    bf16* O; bf16* VT; const float* rs; const float* cs;
    __device__ __forceinline__ void operator()(const f32x4 (&acc)[2][2][4][2], const Unit& u, int wr, int wc, int fr, int fq) const {
        const int row0 = u.pm * BM + wr * 64 + fr, col0 = u.pn * BM + wc * 32 + 8 * fq;
        f32x4 cv[2][2];
#pragma unroll
        for (int bj = 0; bj < 2; ++bj)
#pragma unroll
            for (int n = 0; n < 2; ++n) cv[bj][n] = *(const f32x4*)(cs + col0 + bj * HALF + 4 * n);
        if (u.pn == 6) {
            const int m0 = u.pm * BM; int b, tb;
            if (m0 < ML) { b = m0 >> 11; tb = 256 + (m0 - (b << 11)); } else { b = (m0 - ML) >> 8; tb = 0; }
            bf16* vb = VT + (size_t)b * 256 * VT_LD + tb + wr * 64 + fr;
            const int c0 = wc * 32 + 8 * fq;
#pragma unroll
            for (int ai = 0; ai < 2; ++ai)
#pragma unroll
                for (int m = 0; m < 4; ++m) { const float rsv = rs[row0 + ai * HALF + m * 16];
#pragma unroll
                    for (int bj = 0; bj < 2; ++bj)
#pragma unroll
                        for (int n = 0; n < 2; ++n)
#pragma unroll
                            for (int e = 0; e < 4; ++e) vb[(size_t)(c0 + bj * HALF + 4 * n + e) * VT_LD + ai * HALF + m * 16] = f2bf((float)__float_as_int(acc[ai][bj][m][n][e]) * (rsv * cv[bj][n][e])); }
            return;
        }
        float rsa[2][4];
#pragma unroll
        for (int ai = 0; ai < 2; ++ai)
#pragma unroll
            for (int m = 0; m < 4; ++m) rsa[ai][m] = rs[row0 + ai * HALF + m * 16];
        __builtin_amdgcn_sched_barrier(0);
#pragma unroll
        for (int ai = 0; ai < 2; ++ai)
#pragma unroll
            for (int m = 0; m < 4; ++m) { const int row = row0 + ai * HALF + m * 16; const float rsv = rsa[ai][m]; bf16* rowp = O + (size_t)row * NPR + col0;
#pragma unroll
                for (int bj = 0; bj < 2; ++bj) { float v[8];
#pragma unroll
                    for (int n = 0; n < 2; ++n)
#pragma unroll
                        for (int e = 0; e < 4; ++e) v[n * 4 + e] = (float)__float_as_int(acc[ai][bj][m][n][e]) * (rsv * cv[bj][n][e]);
                    u32x4 w; w.x = pack2(v[0], v[1]); w.y = pack2(v[2], v[3]); w.z = pack2(v[4], v[5]); w.w = pack2(v[6], v[7]);
                    *(u32x4*)(rowp + bj * HALF) = w; } }
    }
};
struct EpiSwiglu {
    static constexpr bool PERM = true;
    bf16* Hd; int ldc;
    __device__ __forceinline__ void operator()(const f32x4 (&acc)[2][2][4][2], const Unit& u, int wr, int wc, int fr, int fq) const {
        const int row0 = u.pm * BM + wr * 64 + fr, col0 = u.pn * HALF + wc * 32 + 8 * fq;
#pragma unroll
        for (int ai = 0; ai < 2; ++ai)
#pragma unroll
            for (int m = 0; m < 4; ++m) { bf16* rowp = Hd + (size_t)(row0 + ai * HALF + m * 16) * ldc + col0;
                float h[8];
#pragma unroll
                for (int n = 0; n < 2; ++n)
#pragma unroll
                    for (int j = 0; j < 4; ++j) { const float g = acc[ai][0][m][n][j], uu = acc[ai][1][m][n][j]; h[n * 4 + j] = g * __builtin_amdgcn_rcpf(1.0f + __expf(-g)) * uu; }
                u32x4 w; w.x = pack2(h[0], h[1]); w.y = pack2(h[2], h[3]); w.z = pack2(h[4], h[5]); w.w = pack2(h[6], h[7]);
                *(u32x4*)rowp = w; }
    }
};
struct EpiSwigluI8 {
    static constexpr bool PERM = true;
    bf16* Hd; int ldc; const float* rs; const float* cs; int F;
    __device__ __forceinline__ void operator()(const f32x4 (&acc)[2][2][4][2], const Unit& u, int wr, int wc, int fr, int fq) const {
        const int row0 = u.pm * BM + wr * 64 + fr, col0 = u.pn * HALF + wc * 32 + 8 * fq;
        const f32x4 cg0 = *(const f32x4*)(cs + col0), cg1 = *(const f32x4*)(cs + col0 + 4), cu0 = *(const f32x4*)(cs + F + col0), cu1 = *(const f32x4*)(cs + F + col0 + 4);
        float rsa[2][4];
#pragma unroll
        for (int ai = 0; ai < 2; ++ai)
#pragma unroll
            for (int m = 0; m < 4; ++m) rsa[ai][m] = rs[row0 + ai * HALF + m * 16];
        __builtin_amdgcn_sched_barrier(0);
#pragma unroll
        for (int ai = 0; ai < 2; ++ai)
#pragma unroll
            for (int m = 0; m < 4; ++m) { const int row = row0 + ai * HALF + m * 16; const float rsv = rsa[ai][m]; bf16* rowp = Hd + (size_t)row * ldc + col0;
                float h[8];
#pragma unroll
                for (int n = 0; n < 2; ++n)
#pragma unroll
                    for (int j = 0; j < 4; ++j) { const float g = (float)__float_as_int(acc[ai][0][m][n][j]) * (rsv * (n ? cg1[j] : cg0[j])), uu = (float)__float_as_int(acc[ai][1][m][n][j]) * (rsv * (n ? cu1[j] : cu0[j]));
                        h[n * 4 + j] = g * __builtin_amdgcn_rcpf(1.0f + __expf(-g)) * uu; }
                u32x4 w; w.x = pack2(h[0], h[1]); w.y = pack2(h[2], h[3]); w.z = pack2(h[4], h[5]); w.w = pack2(h[6], h[7]);
                *(u32x4*)rowp = w; }
    }
};
struct EpiSwigluF8 {
    static constexpr bool PERM = true;
    unsigned char* Hd;
    __device__ __forceinline__ void operator()(const f32x4 (&acc)[2][2][4][2], const Unit& u, int wr, int wc, int fr, int fq) const {
        const int row0 = u.pm * BM + wr * 64 + fr, col0 = u.pn * HALF + wc * 32 + 8 * fq;
#pragma unroll
        for (int ai = 0; ai < 2; ++ai)
#pragma unroll
            for (int m = 0; m < 4; ++m) { unsigned char* rowp = Hd + (size_t)(row0 + ai * HALF + m * 16) * DFEP + col0;
                float h[8];
#pragma unroll
                for (int n = 0; n < 2; ++n)
#pragma unroll
                    for (int j = 0; j < 4; ++j) { const float g = acc[ai][0][m][n][j] * (1.0f / W8S), uu = acc[ai][1][m][n][j] * (H8S / W8S); h[n * 4 + j] = g * __builtin_amdgcn_rcpf(1.0f + __expf(-g)) * uu; }
                u32x2 w; w.x = pack4_fp8(h[0], h[1], h[2], h[3]); w.y = pack4_fp8(h[4], h[5], h[6], h[7]);
                *(u32x2*)rowp = w;
                if (u.pn == DFE / HALF - 1) *(u32x2*)(rowp + HALF) = (u32x2){0u, 0u}; }
    }
};
struct EpiMoeOut {
    static constexpr bool PERM = true;
    bf16* Y; const int* rowtok; const float* gates;
    __device__ __forceinline__ void operator()(const f32x4 (&acc)[2][2][4][2], const Unit& u, int wr, int wc, int fr, int fq) const {
        const int prow0 = u.ploc * BM + wr * 64 + fr, col0 = u.pn * BM + wc * 32 + 8 * fq;
        int ts[2][4]; float gt[2][4];
#pragma unroll
        for (int ai = 0; ai < 2; ++ai)
#pragma unroll
            for (int m = 0; m < 4; ++m) ts[ai][m] = rowtok[u.ex * 65536 + prow0 + ai * HALF + m * 16];
#pragma unroll
        for (int ai = 0; ai < 2; ++ai)
#pragma unroll
            for (int m = 0; m < 4; ++m) gt[ai][m] = gates[max(ts[ai][m], 0)] * (1.0f / (W8S * H8S));
        __builtin_amdgcn_sched_barrier(0);
#pragma unroll
        for (int ai = 0; ai < 2; ++ai)
#pragma unroll
            for (int m = 0; m < 4; ++m) {
                if (ts[ai][m] >= 0) { const float g = gt[ai][m]; bf16* rowp = Y + (size_t)ts[ai][m] * DM + col0;
#pragma unroll
                    for (int bj = 0; bj < 2; ++bj) { const f32x4 v0 = acc[ai][bj][m][0] * g, v1 = acc[ai][bj][m][1] * g;
                        u32x4 w; w.x = pack2(v0[0], v0[1]); w.y = pack2(v0[2], v0[3]); w.z = pack2(v1[0], v1[1]); w.w = pack2(v1[2], v1[3]);
                        *(u32x4*)(rowp + bj * HALF) = w; } } }
    }
};
}

struct Args { const float* in[26]; float* out; unsigned char* ws; int ph_lo, ph_hi; };
struct Frame {
    LAS unsigned char* lds; int G, bid, wv;
    float* out; unsigned char* ws;
};
__device__ __forceinline__ const float* inptr(const Frame& F, int i) {
    const LAS unsigned* t = (const LAS unsigned*)(F.lds + LDSCTL_OFF + 16) + 2 * i;
    const unsigned lo = __builtin_amdgcn_readfirstlane(t[0]), hi = __builtin_amdgcn_readfirstlane(t[1]);
    const GAS float* gp = (const GAS float*)(((unsigned long long)hi << 32) | lo);
    return (const float*)gp;
}
enum { I_X = 0, I_C, I_CTX, I_CCTX, I_WADA, I_BADA, I_GMIX, I_GFFN, I_WIN, I_WOUT, I_POOLW, I_POOLS, I_CONVW, I_RPB, I_SCW, I_SCB, I_SDTB, I_SALOG, I_SD, I_SNG, I_FGU, I_FDOWN, I_ROUTER, I_MGU, I_MDOWN, I_GFINAL };

#define PHASE_IDS const int lane = lane_id_fresh(), wave = F.wv, tid = wave * 64 + lane; (void)lane; (void)wave; (void)tid;
struct TJob { const float* src; bf16* dst; const float* cs; int ldn, k0, n0, ldk, Fm, f8; };
__device__ __forceinline__ void tconv_load(const TJob& J, int tid, f32x4& v0, f32x4& v1) {
    const int r = tid >> 4, c4 = tid & 15;
    const GAS float* p = (const GAS float*)J.src + (size_t)(J.k0 + r) * J.ldn + J.n0 + 4 * c4;
    v0 = *(const GAS f32x4*)p; v1 = *(const GAS f32x4*)(p + (size_t)32 * J.ldn);
}
__device__ __forceinline__ void tconv_lds(const f32x4& v0, const f32x4& v1, LAS float* tile, int tid) {
    const int r = tid >> 4, c4 = tid & 15;
    { LAS float* t = tile + r * 65 + 4 * c4; t[0] = v0[0]; t[1] = v0[1]; t[2] = v0[2]; t[3] = v0[3]; }
    { LAS float* t = tile + (r + 32) * 65 + 4 * c4; t[0] = v1[0]; t[1] = v1[1]; t[2] = v1[2]; t[3] = v1[3]; }
}
__device__ __forceinline__ void tconv_emit(const TJob& J, const LAS float* tile, int tid) {
    const int n = tid >> 3, ks = tid & 7;
    float f[8];
#pragma unroll
    for (int i = 0; i < 8; ++i) f[i] = tile[(ks * 8 + i) * 65 + n];
    const int nn = J.n0 + n; int drow = nn;
    if (J.Fm) { const int isu = nn >= J.Fm; const int j = isu ? nn - J.Fm : nn; drow = (j >> 7) * 256 + (isu ? 128 : 0) + (j & 127); }
    if (J.f8 == 2) { const float inv = 1.0f / J.cs[nn]; u32x2 w8; w8.x = pack4_i8(f[0] * inv, f[1] * inv, f[2] * inv, f[3] * inv); w8.y = pack4_i8(f[4] * inv, f[5] * inv, f[6] * inv, f[7] * inv);
        *(u32x2*)((unsigned char*)J.dst + (size_t)drow * J.ldk + J.k0 + ks * 8) = w8; }
    else if (J.f8) { u32x2 w8; w8.x = pack4_fp8(f[0] * W8S, f[1] * W8S, f[2] * W8S, f[3] * W8S); w8.y = pack4_fp8(f[4] * W8S, f[5] * W8S, f[6] * W8S, f[7] * W8S);
        *(u32x2*)((unsigned char*)J.dst + (size_t)drow * J.ldk + J.k0 + ks * 8) = w8; }
    else { u32x4 w; w.x = pack2(f[0], f[1]); w.y = pack2(f[2], f[3]); w.z = pack2(f[4], f[5]); w.w = pack2(f[6], f[7]);
        *(u32x4*)(J.dst + (size_t)drow * J.ldk + J.k0 + ks * 8) = w; }
}
__device__ __forceinline__ TJob tdecode(const Frame& F, int T) {
    unsigned char* wb = F.ws + WS_WB;
    TJob J; J.Fm = 0; J.f8 = 0; J.cs = nullptr;
    if (T < 1408) { const int l = T / 704, t = T % 704; J.src = inptr(F, I_WIN) + (size_t)l * DM * DIN; J.ldn = DIN; J.k0 = (t / 44) * 64; J.n0 = (t % 44) * 64; J.dst = (bf16*)(wb + WB_IN + l * WB_IN_SZ); J.ldk = DM;
        J.f8 = 2; J.cs = (const float*)(F.ws + WS_CSIN) + l * NPR; }
    else if (T < 1920) { const int q = T - 1408, l = q / 256, t = q % 256; J.src = inptr(F, I_WOUT) + (size_t)l * DM * DM; J.ldn = DM; J.k0 = (t / 16) * 64; J.n0 = (t % 16) * 64; J.dst = (bf16*)(wb + WB_OUT + l * WB_OUT_SZ); J.ldk = DM; }
    else if (T < 3328) { const int t = T - 1920; J.src = inptr(F, I_FGU); J.ldn = 2 * DFF; J.k0 = (t / 88) * 64; J.n0 = (t % 88) * 64; J.dst = (bf16*)(wb + WB_GU); J.ldk = DM; J.Fm = DFF; J.f8 = 2; J.cs = (const float*)(F.ws + WS_CS); }
    else if (T < 4032) { const int t = T - 3328; J.src = inptr(F, I_FDOWN); J.ldn = DM; J.k0 = (t / 16) * 64; J.n0 = (t % 16) * 64; J.dst = (bf16*)(wb + WB_DOWN); J.ldk = DFF; }
    else if (T < 9664) { const int q = T - 4032, e = q / 704, t = q % 704; J.src = inptr(F, I_MGU) + (size_t)e * DM * 2 * DFE; J.ldn = 2 * DFE; J.k0 = (t / 44) * 64; J.n0 = (t % 44) * 64; J.dst = (bf16*)(wb + WB_MGU + e * WB_MGU_SZ); J.ldk = DM; J.Fm = DFE; J.f8 = 1; }
    else { const int q = T - 9664, e = q / 352, t = q % 352; J.src = inptr(F, I_MDOWN) + (size_t)e * DFE * DM; J.ldn = DM; J.k0 = (t / 16) * 64; J.n0 = (t % 16) * 64; J.dst = (bf16*)(wb + WB_MDOWN + e * WB_MDOWN_SZ); J.ldk = DFEP; J.f8 = 1; }
    return J;
}
__device__ __forceinline__ void conv_tiles(const Frame& F, const int lo0, const int n0, const int lo1, const int n1, const int w, const int nw) {
    PHASE_IDS
    constexpr int NT = 4;
    LAS float* ldsf = (LAS float*)F.lds;
    const int nT = n0 + n1;
#define TV(v) ((v) < n0 ? lo0 + (v) : lo1 + ((v) - n0))
    int g = w;
    if (g * NT >= nT) return;
    f32x4 cv[NT][2], nv[NT][2];
#pragma unroll
    for (int j = 0; j < NT; ++j) { cv[j][0] = cv[j][1] = (f32x4){0.f, 0.f, 0.f, 0.f}; if (g * NT + j < nT) { const TJob J = tdecode(F, TV(g * NT + j)); tconv_load(J, tid, cv[j][0], cv[j][1]); } }
    for (; g * NT < nT; g += nw) {
        const int gn = g + nw;
#pragma unroll
        for (int j = 0; j < NT; ++j) { nv[j][0] = cv[j][0]; nv[j][1] = cv[j][1]; if (gn * NT + j < nT) { const TJob J = tdecode(F, TV(gn * NT + j)); tconv_load(J, tid, nv[j][0], nv[j][1]); } }
#pragma unroll
        for (int j = 0; j < NT; ++j) if (g * NT + j < nT) tconv_lds(cv[j][0], cv[j][1], ldsf + j * (64 * 65), tid);
        __syncthreads();
#pragma unroll
        for (int j = 0; j < NT; ++j) if (g * NT + j < nT) { const TJob J = tdecode(F, TV(g * NT + j)); tconv_emit(J, ldsf + j * (64 * 65), tid); }
        __syncthreads();
#pragma unroll
        for (int j = 0; j < NT; ++j) { cv[j][0] = nv[j][0]; cv[j][1] = nv[j][1]; }
    }
#undef TV
}
__device__ __forceinline__ bool tail_worker(const Frame& F, int nunits, int& w, int& nw) { const int r = nunits % F.G; w = F.bid - r; nw = F.G - r; return F.bid >= r; }
__device__ __forceinline__ void p0_prologue(const Frame& F) {
    PHASE_IDS
    unsigned char* wb = F.ws + WS_WB;
    LAS float* ldsf = (LAS float*)F.lds;
    if (F.bid < 192) {
        constexpr int ADA_LD = 1028;
        const int l = F.bid / 96, cg = F.bid % 96;
        { const GAS float* cl = (const GAS float*)inptr(F, I_C); const GAS float* cx = (const GAS float*)inptr(F, I_CCTX);
          f32x4 cv[17];
#pragma unroll
          for (int it = 0; it < 17; ++it) { const int i4 = tid + 512 * it, b = i4 >> 8, k4 = i4 & 255; cv[it] = (f32x4){0.f, 0.f, 0.f, 0.f};
              if (i4 < 33 * 256) cv[it] = (b < 32) ? *(const GAS f32x4*)(cl + b * 1024 + 4 * k4) : *(const GAS f32x4*)(cx + 4 * k4); }
#pragma unroll
          for (int it = 0; it < 17; ++it) { const int i4 = tid + 512 * it, b = i4 >> 8, k4 = i4 & 255;
              if (i4 < 33 * 256) { f32x4 sv; sv[0] = silu_f(cv[it][0]); sv[1] = silu_f(cv[it][1]); sv[2] = silu_f(cv[it][2]); sv[3] = silu_f(cv[it][3]); *(LAS f32x4*)(ldsf + b * ADA_LD + 4 * k4) = sv; } } }
        __syncthreads();
        const int lq = lane & 15, g = lane >> 4;
        f32x4 acc[3][4];
#pragma unroll
        for (int mt = 0; mt < 3; ++mt)
#pragma unroll
            for (int nt = 0; nt < 4; ++nt) acc[mt][nt] = (f32x4){0.f, 0.f, 0.f, 0.f};
        const GAS float* wbase = (const GAS float*)inptr(F, I_WADA) + (size_t)l * 1024 * 6144 + cg * 64 + lq + (size_t)(wave * 128 + 8 * g) * 6144;
        float wc[4][8], wn[4][8];
#define ADA_WLOAD(dst, ks) do { _Pragma("unroll") for (int nt = 0; nt < 4; ++nt) _Pragma("unroll") for (int j = 0; j < 8; ++j) dst[nt][j] = wbase[(size_t)((ks) * 32 + j) * 6144 + 16 * nt]; } while (0)
#define ADA_SPLIT(v, hi, lo) do { u32x4 h_, l_; _Pragma("unroll") for (int i = 0; i < 4; ++i) { const unsigned ph_ = pack2(v[2 * i], v[2 * i + 1]); h_[i] = ph_; l_[i] = pack2(v[2 * i] - bflo(ph_), v[2 * i + 1] - bfhi(ph_)); } \
            hi = __builtin_bit_cast(bf16x8, h_); lo = __builtin_bit_cast(bf16x8, l_); } while (0)
        ADA_WLOAD(wc, 0);
#pragma unroll
        for (int ks = 0; ks < 4; ++ks) {
            if (ks + 1 < 4) ADA_WLOAD(wn, ks + 1);
            bf16x8 ah[3], al[3];
#pragma unroll
            for (int mt = 0; mt < 3; ++mt) { const int row = min(16 * mt + lq, 32); const LAS float* ap = ldsf + row * ADA_LD + wave * 128 + ks * 32 + 8 * g;
                const f32x4 a0 = *(const LAS f32x4*)ap, a1 = *(const LAS f32x4*)(ap + 4); const float av[8] = {a0[0], a0[1], a0[2], a0[3], a1[0], a1[1], a1[2], a1[3]};
                ADA_SPLIT(av, ah[mt], al[mt]); }
#pragma unroll
            for (int nt = 0; nt < 4; ++nt) { bf16x8 wh, wl; ADA_SPLIT(wc[nt], wh, wl);
#pragma unroll
                for (int mt = 0; mt < 3; ++mt) { acc[mt][nt] = __builtin_amdgcn_mfma_f32_16x16x32_bf16(ah[mt], wh, acc[mt][nt], 0, 0, 0); acc[mt][nt] = __builtin_amdgcn_mfma_f32_16x16x32_bf16(ah[mt], wl, acc[mt][nt], 0, 0, 0);
                    acc[mt][nt] = __builtin_amdgcn_mfma_f32_16x16x32_bf16(al[mt], wh, acc[mt][nt], 0, 0, 0); } }
#pragma unroll
            for (int nt = 0; nt < 4; ++nt)
#pragma unroll
                for (int j = 0; j < 8; ++j) wc[nt][j] = wn[nt][j];
        }
#undef ADA_WLOAD
#undef ADA_SPLIT
        __syncthreads();
#pragma unroll
        for (int mt = 0; mt < 3; ++mt)
#pragma unroll
            for (int nt = 0; nt < 4; ++nt) *(LAS f32x4*)(ldsf + ((wave * 12 + mt * 4 + nt) * 64 + lane) * 4) = acc[mt][nt];
        __syncthreads();
        float* mod = (float*)(F.ws + WS_MOD) + (size_t)l * 33 * 6144;
        for (int idx = tid; idx < 33 * 64; idx += 512) { const int b = idx >> 6, n = idx & 63; const int mt = b >> 4, gg = (b & 15) >> 2, e = b & 3, nt = n >> 4, ll = gg * 16 + (n & 15); float sm = 0.f;
#pragma unroll
            for (int w = 0; w < 8; ++w) sm += ldsf[((w * 12 + mt * 4 + nt) * 64 + ll) * 4 + e];
            mod[(size_t)b * 6144 + cg * 64 + n] = sm + inptr(F, I_BADA)[l * 6144 + cg * 64 + n]; }
        __syncthreads();
    }
    for (int cgp = F.G - 1 - F.bid; cgp < 176; cgp += F.G) {
        const bool isin = cgp >= 88; const int lyr = cgp >= 132; const int n0 = (isin ? (cgp - 88) % 44 : cgp) * 64; const int ldw = isin ? DIN : 2 * DFF;
        const int c4 = tid & 15, ks = tid >> 4;
        const GAS float* wsrc = (const GAS float*)(isin ? inptr(F, I_WIN) + (size_t)lyr * DM * DIN : inptr(F, I_FGU)) + n0 + 4 * c4 + (size_t)(ks * 32) * ldw;
        f32x4 am = (f32x4){0.f, 0.f, 0.f, 0.f};
#pragma unroll
        for (int k = 0; k < 32; ++k) { const f32x4 v = *(const GAS f32x4*)(wsrc + (size_t)k * ldw); am[0] = fmaxf(am[0], fabsf(v[0])); am[1] = fmaxf(am[1], fabsf(v[1])); am[2] = fmaxf(am[2], fabsf(v[2])); am[3] = fmaxf(am[3], fabsf(v[3])); }
        __syncthreads();
        *(LAS f32x4*)(ldsf + ks * 64 + 4 * c4) = am;
        __syncthreads();
        if (tid < 64) { float m8 = 0.f;
#pragma unroll
            for (int q = 0; q < 32; ++q) m8 = fmaxf(m8, ldsf[q * 64 + tid]);
            ((float*)(F.ws + (isin ? WS_CSIN : WS_CS)))[lyr * NPR + n0 + tid] = fmaxf(m8, 1.0e-20f) * (1.0f / 127.0f); }
        __syncthreads(); }
    for (int idx = F.bid * 512 + tid; idx < NEXP * 65536 / 4; idx += F.G * 512) *(u32x4*)(F.ws + WS_LISTE + (size_t)idx * 16) = (u32x4){0xFFFFFFFFu, 0xFFFFFFFFu, 0xFFFFFFFFu, 0xFFFFFFFFu};
    for (int idx = F.bid * 512 + tid; idx < NEXP * DM * 8; idx += F.G * 512) { const int rr = idx >> 3, q = idx & 7; *(u32x4*)(wb + WB_MDOWN + (size_t)rr * DFEP + DFE + q * 16) = (u32x4){0u, 0u, 0u, 0u}; }
}

template <int L, int MODE, bool SRC_XR, bool HAS_D>
__device__ __forceinline__ void norm_phase(const Frame& F, int nrows, const bf16* Dbuf, const float* gate) {
    PHASE_IDS
    const float* mod = (const float*)(F.ws + WS_MOD) + (size_t)L * 33 * 6144;
    constexpr bool M0 = (MODE == 0 || MODE == 6);
    const int sh_off = M0 ? 0 : 3 * 1024, sc_off = sh_off + 1024;
    const float* gsrc = (M0 ? inptr(F, I_GMIX) : inptr(F, I_GFFN)) + L * DM;
    bf16* HB = (bf16*)(F.ws + WS_HB);
    float* DT = (float*)(F.ws + WS_DT);
    bf16* XR = (bf16*)(F.ws + WS_XR);
    f32x4 wx[16][2];
    if (M0 || MODE == 2) {
#pragma unroll
        for (int j = 0; j < 4; ++j)
#pragma unroll
            for (int i = 0; i < 4; ++i) { const int k = j * 256 + lane * 4 + i;
                const float* p = M0 ? inptr(F, I_WIN) + (size_t)L * DM * DIN + (size_t)k * DIN + NPR : inptr(F, I_ROUTER) + (size_t)k * NEXP;
                wx[j * 4 + i][0] = *(const f32x4*)p; wx[j * 4 + i][1] = *(const f32x4*)(p + 4); }
    }
    const int per = (nrows + F.G * 8 - 1) / (F.G * 8), mbeg = (F.bid * 8 + wave) * per, mend = min(mbeg + per, nrows);
    f32x4 ga[4], sha[4], gtv[4]; int curmod = -1; int my_i1 = -1, my_i2 = -1;
    f32x4 v[4], vn[4]; u32x2 xb[4], xbn[4], dl[4], dln[4];
    const GAS float* xlat_p = (const GAS float*)inptr(F, I_X); const GAS float* xctx_p = (const GAS float*)inptr(F, I_CTX);
#define NP_LOAD(m, V, XB, DL) do { \
        if (SRC_XR) { const GAS bf16* s_ = (const GAS bf16*)XR + (size_t)(m) * DM + lane * 4; _Pragma("unroll") for (int j = 0; j < 4; ++j) XB[j] = *(const GAS u32x2*)(s_ + j * 256); } \
        else { const GAS float* s_ = (((m) < ML) ? xlat_p + (size_t)(m) * DM : xctx_p + (size_t)((m) - ML) * DM) + lane * 4; _Pragma("unroll") for (int j = 0; j < 4; ++j) V[j] = *(const GAS f32x4*)(s_ + j * 256); } \
        if (HAS_D) { const GAS bf16* d_ = (const GAS bf16*)Dbuf + (size_t)(m) * DM + lane * 4; _Pragma("unroll") for (int j = 0; j < 4; ++j) DL[j] = *(const GAS u32x2*)(d_ + j * 256); } } while (0)
    if (mbeg < mend) NP_LOAD(mbeg, v, xb, dl);
    for (int m = mbeg; m < mend; ++m) {
        if (m + 1 < mend) NP_LOAD(m + 1, vn, xbn, dln);
        const int mi = modidx_of(m);
        if (mi != curmod) { curmod = mi; const float* mrow = mod + (size_t)mi * 6144;
#pragma unroll
            for (int j = 0; j < 4; ++j) { const int e = j * 256 + lane * 4; const f32x4 g = *(const f32x4*)(gsrc + e), sc = *(const f32x4*)(mrow + sc_off + e); ga[j] = g * (sc + 1.0f); sha[j] = *(const f32x4*)(mrow + sh_off + e);
                if (HAS_D) gtv[j] = *(const f32x4*)(gate + (size_t)mi * 6144 + e); } }
        float ss = 0.f;
#pragma unroll
        for (int j = 0; j < 4; ++j) {
            if (SRC_XR) { v[j][0] = bflo(xb[j].x); v[j][1] = bfhi(xb[j].x); v[j][2] = bflo(xb[j].y); v[j][3] = bfhi(xb[j].y); }
            if (HAS_D) { f32x4 dv; dv[0] = bflo(dl[j].x); dv[1] = bfhi(dl[j].x); dv[2] = bflo(dl[j].y); dv[3] = bfhi(dl[j].y); v[j] = v[j] + gtv[j] * dv;
                u32x2 w; w.x = pack2(v[j][0], v[j][1]); w.y = pack2(v[j][2], v[j][3]); *(u32x2*)(XR + (size_t)m * DM + j * 256 + lane * 4) = w; }
            ss += v[j][0] * v[j][0] + v[j][1] * v[j][1] + v[j][2] * v[j][2] + v[j][3] * v[j][3];
        }
        ss = wave_sum(ss);
        const float rstd = rsqrtf(ss * (1.0f / DM) + EPS);
        float d8[8];
#pragma unroll
        for (int q = 0; q < 8; ++q) d8[q] = 0.f;
        if (MODE == 5) {
            f32x4 hh[4]; float am = 0.f;
#pragma unroll
            for (int j = 0; j < 4; ++j) { hh[j] = v[j] * rstd * ga[j] + sha[j]; am = fmaxf(am, fmaxf(fmaxf(fabsf(hh[j][0]), fabsf(hh[j][1])), fmaxf(fabsf(hh[j][2]), fabsf(hh[j][3])))); }
            am = fmaxf(wave_max_dpp(am), 1.0e-20f);
            const float inv = 127.0f / am;
#pragma unroll
            for (int j = 0; j < 4; ++j) *(unsigned*)((unsigned char*)HB + (size_t)m * DM + j * 256 + lane * 4) = pack4_i8(hh[j][0] * inv, hh[j][1] * inv, hh[j][2] * inv, hh[j][3] * inv);
            if (lane == 0) ((float*)(F.ws + WS_RS))[m] = am * (1.0f / 127.0f);
        }
        f32x4 hq[4]; float amq = 0.f; (void)hq;
        if (MODE != 5) {
#pragma unroll
        for (int j = 0; j < 4; ++j) {
            const int e = j * 256 + lane * 4;
            f32x4 h = v[j] * rstd * ga[j] + sha[j];
            if (MODE == 2) *(unsigned*)((unsigned char*)HB + (size_t)m * DM + e) = pack4_fp8(h[0], h[1], h[2], h[3]);
            else if (MODE == 6) { hq[j] = h; amq = fmaxf(amq, fmaxf(fmaxf(fabsf(h[0]), fabsf(h[1])), fmaxf(fabsf(h[2]), fabsf(h[3])))); }
            else { u32x2 w; w.x = pack2(h[0], h[1]); w.y = pack2(h[2], h[3]); *(u32x2*)(HB + (size_t)m * DM + e) = w; }
            if (M0 || MODE == 2) {
#pragma unroll
                for (int i = 0; i < 4; ++i) {
#pragma unroll
                    for (int q = 0; q < 4; ++q) { d8[q] += h[i] * wx[j * 4 + i][0][q]; d8[4 + q] += h[i] * wx[j * 4 + i][1][q]; } }
            }
        }
        }
        if (MODE == 6) { amq = fmaxf(wave_max_dpp(amq), 1.0e-20f); const float inv = 127.0f / amq;
#pragma unroll
            for (int j = 0; j < 4; ++j) *(unsigned*)((unsigned char*)HB + (size_t)m * DM + j * 256 + lane * 4) = pack4_i8(hq[j][0] * inv, hq[j][1] * inv, hq[j][2] * inv, hq[j][3] * inv);
            if (lane == 0) ((float*)(F.ws + WS_RS))[m] = amq * (1.0f / 127.0f); }
        float dred = 0.f;
        if (M0 || MODE == 2) {
            const bool h5 = (lane & 32) != 0, h4 = (lane & 16) != 0, h3 = (lane & 8) != 0;
            float a4[4];
#pragma unroll
            for (int q = 0; q < 4; ++q) { const float keep = h5 ? d8[4 + q] : d8[q], send = h5 ? d8[q] : d8[4 + q]; a4[q] = keep + __shfl_xor(send, 32); }
            float a2[2];
#pragma unroll
            for (int q = 0; q < 2; ++q) { const float keep = h4 ? a4[2 + q] : a4[q], send = h4 ? a4[q] : a4[2 + q]; a2[q] = keep + __shfl_xor(send, 16); }
            { const float keep = h3 ? a2[1] : a2[0], send = h3 ? a2[0] : a2[1]; dred = keep + __shfl_xor(send, 8); }
            dred = row8_sum(dred);
        }
        if (M0) {
            if ((lane & 7) == 0) DT[(size_t)m * 8 + (lane >> 3)] = dred;
        }
        if (MODE == 2) {
#pragma unroll
            for (int q = 0; q < 8; ++q) d8[q] = __shfl(dred, 8 * q);
            int i1 = 0; float v1 = d8[0];
#pragma unroll
            for (int q = 1; q < 8; ++q) if (d8[q] > v1) { v1 = d8[q]; i1 = q; }
            int i2 = -1; float v2 = -3.0e38f;
#pragma unroll
            for (int q = 0; q < 8; ++q) if (q != i1 && d8[q] > v2) { v2 = d8[q]; i2 = q; }
            if (lane == 0) {
                const float g1 = 1.0f / (1.0f + __expf(v2 - v1));
                int* te = (int*)(F.ws + WS_ROUTE); float* tg = (float*)(te + 4 * ML);
                te[2 * m] = i1; te[2 * m + 1] = i2; tg[2 * m] = g1; tg[2 * m + 1] = 1.0f - g1;
            }
            if (lane == m - mbeg) { my_i1 = i1; my_i2 = i2; }
        }
#pragma unroll
        for (int j = 0; j < 4; ++j) { v[j] = vn[j]; xb[j] = xbn[j]; dl[j] = dln[j]; }
    }
#undef NP_LOAD
    if (MODE == 2) {
        LAS unsigned* lc = (LAS unsigned*)F.lds;
        __syncthreads();
        if (tid < 16) lc[tid] = 0u;
        __syncthreads();
        unsigned wbase1 = 0u, rank1 = 0u, rank2 = 0u; unsigned n1mine = 0u;
        const unsigned long long lt = (lane == 0) ? 0ull : (~0ull >> (64 - lane));
#pragma unroll
        for (int e = 0; e < 8; ++e) {
            const unsigned long long m1 = __ballot(my_i1 == e), m2 = __ballot(my_i2 == e);
            const unsigned c1 = (unsigned)__popcll(m1), c2 = (unsigned)__popcll(m2);
            unsigned wb = 0u;
            if (lane == 0 && (c1 + c2) != 0u) wb = __hip_atomic_fetch_add(lc + e, c1 + c2, __ATOMIC_RELAXED, __HIP_MEMORY_SCOPE_WORKGROUP);
            wb = (unsigned)__shfl((int)wb, 0);
            if (my_i1 == e) { wbase1 = wb; rank1 = (unsigned)__popcll(m1 & lt); }
            if (my_i2 == e) { n1mine = wb + c1; rank2 = (unsigned)__popcll(m2 & lt); }
        }
        __syncthreads();
        if (tid < 8) { const unsigned c = lc[tid]; lc[8 + tid] = c ? atomicAdd((unsigned*)(F.ws + WS_CTL) + CW_CNT + tid * 64, c) : 0u; }
        __syncthreads();
        if (my_i1 >= 0) { const int m = mbeg + lane; int* liste = (int*)(F.ws + WS_LISTE);
            liste[my_i1 * 65536 + (int)(lc[8 + my_i1] + wbase1 + rank1)] = 2 * m; liste[my_i2 * 65536 + (int)(lc[8 + my_i2] + n1mine + rank2)] = 2 * m + 1; }
        __syncthreads();
    }
}

constexpr int SS_LD = 272;
constexpr int SS_BM = 0, SS_CM = 128 * SS_LD, SS_BT = 2 * 128 * SS_LD, SS_XT = 3 * 128 * SS_LD, SS_HS = SS_XT + 64 * SS_LD, SS_AC = SS_HS + 64 * SS_LD, SS_DT = SS_AC + 512, SS_SC = SS_DT + 512;
static_assert(SS_SC + 512 <= LDSCTL_OFF, "ssd LDS map");
template <int V> struct IntC { static constexpr int value = V; };
template <int L>
__device__ __forceinline__ void ssd_scan_mfma(const Frame& F, bf16* Yd) {
    PHASE_IDS
    const bf16* PR = (const bf16*)(F.ws + WS_PRB);
    const float* DT = (const float*)(F.ws + WS_DT);
    LAS unsigned char* lb = F.lds;
    LAS float* acum = (LAS float*)(lb + SS_AC); LAS float* dtv = (LAS float*)(lb + SS_DT); LAS float* scl = (LAS float*)(lb + SS_SC);
    const float* cw = inptr(F, I_SCW) + (size_t)L * 3 * 768; const float* cb = inptr(F, I_SCB) + (size_t)L * 768;
    const int lq = lane & 15, g = lane >> 4;
    for (int item = F.bid; item < NB * 2 * 4; item += F.G) {
        const int b = item >> 3, d = (item >> 2) & 1, hd = item & 3, grp = hd >> 1;
        const float a = -__expf(inptr(F, I_SALOG)[(L * 2 + d) * 4 + hd]);
        const float dtb = inptr(F, I_SDTB)[(L * 2 + d) * 4 + hd];
        const float dsk = (d == 0) ? inptr(F, I_SD)[L * 4 + hd] : 0.f;
        const int xix = hd * 64 + lane, xib = 256 + grp * 128 + 2 * lane, xic = 512 + grp * 128 + 2 * lane;
        const float wx0 = cw[xix], wx1 = cw[768 + xix], wx2 = cw[1536 + xix], bx = cb[xix];
        const float wb00 = cw[xib], wb01 = cw[768 + xib], wb02 = cw[1536 + xib], bb0 = cb[xib], wb10 = cw[xib + 1], wb11 = cw[768 + xib + 1], wb12 = cw[1536 + xib + 1], bb1 = cb[xib + 1];
        const float wc00 = cw[xic], wc01 = cw[768 + xic], wc02 = cw[1536 + xic], bc0 = cb[xic], wc10 = cw[xic + 1], wc11 = cw[768 + xic + 1], wc12 = cw[1536 + xic + 1], bc1 = cb[xic + 1];
        f32x4 Hacc[4];
#pragma unroll
        for (int pt = 0; pt < 4; ++pt) Hacc[pt] = (f32x4){0.f, 0.f, 0.f, 0.f};
        __syncthreads();
        for (int i = tid; i < 64 * SS_LD / 4; i += 512) ((LAS unsigned*)(lb + SS_HS))[i] = 0u;
#define SSD_GEOM(chn) const bool isctx = (chn) < 2; const int Ls = isctx ? 256 : 2048, rowbase = isctx ? ML + b * 256 : b * 2048, sb = isctx ? (chn) * 128 : ((chn) - 2) * 128; const int p0 = d ? Ls - 128 - sb : sb;
        unsigned xr[18], br[18], cr[18]; float dtr0 = 0.f, dtr1 = 0.f;
#define SSD_PREFETCH(chn) do { SSD_GEOM(chn) \
            if (wave == 0) { const int pos0 = d ? p0 + 127 - 2 * lane : p0 + 2 * lane, pos1 = d ? pos0 - 1 : pos0 + 1; \
                dtr0 = DT[(size_t)(rowbase + pos0) * 8 + d * 4 + hd]; dtr1 = DT[(size_t)(rowbase + pos1) * 8 + d * 4 + hd]; } \
            const int pw = p0 + 16 * wave - 1; const bool z_lo = (pw < 0), z_hi = (pw + 17 >= Ls); \
            const bf16* pl = PR + (size_t)rowbase * NPR + C_XBC; \
            _Pragma("unroll") for (int k = 0; k < 18; ++k) { const int pos = min(max(pw + k, 0), Ls - 1); const bf16* pp = pl + (size_t)pos * NPR; \
                xr[k] = (unsigned)pp[xix]; br[k] = *(const unsigned*)(pp + xib); cr[k] = *(const unsigned*)(pp + xic); } \
            if (z_lo) { xr[0] = 0u; br[0] = 0u; cr[0] = 0u; } \
            if (z_hi) { xr[17] = 0u; br[17] = 0u; cr[17] = 0u; } } while (0)
        SSD_PREFETCH(0);
#pragma nounroll
        for (int ch = 0; ch < 18; ++ch) {
            SSD_GEOM(ch)
            (void)Ls; (void)sb;
            if (wave == 0) {
                const float dt0 = softplus_f(dtr0 + dtb), dt1 = softplus_f(dtr1 + dtb);
                const float la0 = dt0 * a, ps = la0 + dt1 * a;
                const float v = wave_scan_incl(ps, lane);
                const float base = v - ps;
                acum[2 * lane] = base + la0; acum[2 * lane + 1] = base + ps; dtv[2 * lane] = dt0; dtv[2 * lane + 1] = dt1;
                const float acT = __shfl(v, 63);
                scl[2 * lane] = dt0 * __expf(acT - (base + la0)); scl[2 * lane + 1] = dt1 * __expf(acT - (base + ps));
            }
            __syncthreads();
            { auto stage = [&](auto dc) {
                  constexpr int D = decltype(dc)::value;
                  unsigned px[4], pb0[4], pb1[4]; float xprev = 0.f, t0prev = 0.f, t1prev = 0.f;
                  const int i0b = (D ? 112 - 16 * wave : 16 * wave) * 2;
#pragma unroll
                  for (int k = 0; k < 16; ++k) {
                      const int li = 16 * wave + k, i = D ? 127 - li : li;
                      const float xa = silu_f(wx0 * bf2f(xr[k]) + wx1 * bf2f(xr[k + 1]) + wx2 * bf2f(xr[k + 2]) + bx);
                      const float b0 = silu_f(wb00 * bflo(br[k]) + wb01 * bflo(br[k + 1]) + wb02 * bflo(br[k + 2]) + bb0), b1 = silu_f(wb10 * bfhi(br[k]) + wb11 * bfhi(br[k + 1]) + wb12 * bfhi(br[k + 2]) + bb1);
                      const float c0 = silu_f(wc00 * bflo(cr[k]) + wc01 * bflo(cr[k + 1]) + wc02 * bflo(cr[k + 2]) + bc0), c1 = silu_f(wc10 * bfhi(cr[k]) + wc11 * bfhi(cr[k + 1]) + wc12 * bfhi(cr[k + 2]) + bc1);
                      const float sc = scl[i];
                      *(LAS unsigned*)(lb + SS_BM + i * SS_LD + lane * 4) = pack2(b0, b1);
                      *(LAS unsigned*)(lb + SS_CM + i * SS_LD + lane * 4) = pack2(c0, c1);
                      const float t0 = b0 * sc, t1 = b1 * sc;
                      if (k & 1) { const int q = (k >> 1) & 3; px[q] = D ? pack2(xa, xprev) : pack2(xprev, xa); pb0[q] = D ? pack2(t0, t0prev) : pack2(t0prev, t0); pb1[q] = D ? pack2(t1, t1prev) : pack2(t1prev, t1); }
                      else { xprev = xa; t0prev = t0; t1prev = t1; }
                      if ((k & 7) == 7) {
                          const int ob = i0b + (D ? 16 * (1 - (k >> 3)) : 16 * (k >> 3));
#define SSD_W1(base, P) *(LAS u32x4*)(lb + (base) + ob) = D ? (u32x4){P[3], P[2], P[1], P[0]} : (u32x4){P[0], P[1], P[2], P[3]}
                          SSD_W1(SS_XT + lane * SS_LD, px); SSD_W1(SS_BT + (2 * lane) * SS_LD, pb0); SSD_W1(SS_BT + (2 * lane + 1) * SS_LD, pb1);
#undef SSD_W1
                          __builtin_amdgcn_sched_barrier(0);
                      }
                  }
              };
              if (d) stage(IntC<1>{}); else stage(IntC<0>{}); }
            __syncthreads();
            if (ch + 1 < 18) SSD_PREFETCH(ch + 1);
            {
                const int lt = wave < 4 ? wave : 11 - wave;
                bf16x8 Cf[4];
#pragma unroll
                for (int kk = 0; kk < 4; ++kk) Cf[kk] = *(const LAS bf16x8*)(lb + SS_CM + (16 * lt + lq) * SS_LD + (32 * kk + 8 * g) * 2);
                if (!(L == 1 && ch < 2)) {
                f32x4 Ya[4];
#pragma unroll
                for (int pt = 0; pt < 4; ++pt) { Ya[pt] = (f32x4){0.f, 0.f, 0.f, 0.f};
#pragma unroll
                    for (int kk = 0; kk < 4; ++kk) { const bf16x8 Hf = *(const LAS bf16x8*)(lb + SS_HS + (16 * pt + lq) * SS_LD + (32 * kk + 8 * g) * 2); Ya[pt] = __builtin_amdgcn_mfma_f32_16x16x32_bf16(Hf, Cf[kk], Ya[pt], 0, 0, 0); } }
                const int l = 16 * lt + lq; const float acl = acum[l], el = __expf(acl);
#pragma unroll
                for (int pt = 0; pt < 4; ++pt) Ya[pt] *= el;
#pragma nounroll
                for (int sc = 0; sc <= (lt >> 1); ++sc) {
                    f32x4 G0 = (f32x4){0.f, 0.f, 0.f, 0.f}, G1 = (f32x4){0.f, 0.f, 0.f, 0.f};
                    const int srow0 = 32 * sc + 8 * (lq >> 2) + (lq & 3);
#pragma unroll
                    for (int kk = 0; kk < 4; ++kk) { const bf16x8 A0 = *(const LAS bf16x8*)(lb + SS_BM + srow0 * SS_LD + (32 * kk + 8 * g) * 2), A1 = *(const LAS bf16x8*)(lb + SS_BM + (srow0 + 4) * SS_LD + (32 * kk + 8 * g) * 2);
                        G0 = __builtin_amdgcn_mfma_f32_16x16x32_bf16(A0, Cf[kk], G0, 0, 0, 0); G1 = __builtin_amdgcn_mfma_f32_16x16x32_bf16(A1, Cf[kk], G1, 0, 0, 0); }
                    const int s0 = 32 * sc + 8 * g;
                    const f32x4 as0 = *(const LAS f32x4*)(acum + s0), as1 = *(const LAS f32x4*)(acum + s0 + 4), ds0 = *(const LAS f32x4*)(dtv + s0), ds1 = *(const LAS f32x4*)(dtv + s0 + 4);
                    float pv[8];
#pragma unroll
                    for (int e = 0; e < 4; ++e) { const int sA = s0 + e, sB = s0 + 4 + e;
                        float vA = G0[e] * __expf(acl - as0[e]) * ds0[e], vB = G1[e] * __expf(acl - as1[e]) * ds1[e];
                        vA = (sA == l) ? vA + dsk : vA; vB = (sB == l) ? vB + dsk : vB;
                        pv[e] = (sA <= l) ? vA : 0.f; pv[4 + e] = (sB <= l) ? vB : 0.f; }
                    u32x4 pw4; pw4.x = pack2(pv[0], pv[1]); pw4.y = pack2(pv[2], pv[3]); pw4.z = pack2(pv[4], pv[5]); pw4.w = pack2(pv[6], pv[7]);
                    const bf16x8 pfr = __builtin_bit_cast(bf16x8, pw4);
#pragma unroll
                    for (int pt = 0; pt < 4; ++pt) { const bf16x8 Xf = *(const LAS bf16x8*)(lb + SS_XT + (16 * pt + lq) * SS_LD + s0 * 2); Ya[pt] = __builtin_amdgcn_mfma_f32_16x16x32_bf16(Xf, pfr, Ya[pt], 0, 0, 0); }
                }
                { const int pos = d ? p0 + 127 - l : p0 + l; bf16* yp = Yd + ((size_t)d * MT + rowbase + pos) * 256 + hd * 64 + 4 * g;
#pragma unroll
                  for (int pt = 0; pt < 4; ++pt) { u32x2 yw; yw.x = pack2(Ya[pt][0], Ya[pt][1]); yw.y = pack2(Ya[pt][2], Ya[pt][3]); *(u32x2*)(yp + 16 * pt) = yw; } }
                }
                const float dA = __expf(acum[127]);
#pragma unroll
                for (int pt = 0; pt < 4; ++pt) Hacc[pt] *= dA;
#pragma unroll
                for (int kk = 0; kk < 4; ++kk) { const bf16x8 Bf = *(const LAS bf16x8*)(lb + SS_BT + (16 * wave + lq) * SS_LD + (32 * kk + 8 * g) * 2);
#pragma unroll
                    for (int pt = 0; pt < 4; ++pt) { const bf16x8 Xf = *(const LAS bf16x8*)(lb + SS_XT + (16 * pt + lq) * SS_LD + (32 * kk + 8 * g) * 2); Hacc[pt] = __builtin_amdgcn_mfma_f32_16x16x32_bf16(Bf, Xf, Hacc[pt], 0, 0, 0); } }
            }
            __syncthreads();
#pragma unroll
            for (int pt = 0; pt < 4; ++pt) { u32x2 hw; hw.x = pack2(Hacc[pt][0], Hacc[pt][1]); hw.y = pack2(Hacc[pt][2], Hacc[pt][3]);
                *(LAS u32x2*)(lb + SS_HS + (16 * pt + lq) * SS_LD + (16 * wave + 4 * g) * 2) = hw; }
        }
#undef SSD_PREFETCH
#undef SSD_GEOM
        __syncthreads();
    }
}

constexpr int AW_WIN = 0, AW_CK = 73728, AW_CV = AW_CK + 32768, AW_RPB = AW_CV + 32768;
static_assert(AW_RPB + 4 * 465 * 4 <= LDSCTL_OFF, "attention LDS map");
__device__ __forceinline__ int aw_swzk(int key) { return (key & 7) ^ ((key >> 3) & 3); }
template <int L>
__device__ __forceinline__ void attn_phase(const Frame& F) {
    PHASE_IDS
    const bf16* PR = (const bf16*)(F.ws + WS_PRB); const bf16* VT = (const bf16*)(F.ws + WS_VT); bf16* O = (bf16*)(F.ws + WS_HB);
    LAS unsigned char* lb = F.lds;
    LAS float* rpbL = (LAS float*)(F.lds + AW_RPB);
    __syncthreads();
    for (int i = tid; i < 4 * 465; i += 512) rpbL[i] = inptr(F, I_RPB)[(size_t)L * 4 * 465 + i] * 1.44269504f;
    for (int item = F.bid; item < NB * 4 * 2; item += F.G) {
        const int b = item >> 3, h = (item >> 1) & 3, hf = item & 1;
        __syncthreads();
        int tv = wave * 64 + lane_id_fresh();
#pragma unroll
        for (int i = 0; i < 4; ++i) { const int p = tv + 512 * i;
            { const int key = p >> 3, ch = p & 7; *(LAS u32x4*)(lb + AW_CK + key * 128 + ((ch ^ aw_swzk(key)) << 4)) = *(const u32x4*)(PR + (size_t)(ML + b * 256 + key) * NPR + C_K + h * 64 + ch * 8); }
            { const int vq = p & 3, dim = (p >> 2) & 63, cc = p >> 8; *(LAS u32x4*)(lb + AW_CV + cc * 4096 + dim * 64 + ((vq ^ ((dim >> 2) & 3)) << 4)) = *(const u32x4*)(VT + (size_t)(b * 256 + h * 64 + dim) * VT_LD + cc * 32 + vq * 8); } }
        u32x4 pre[9];
#define AW_KPREF(srA_) do { _Pragma("unroll") for (int i_ = 0; i_ < 9; ++i_) { const int p_ = tv + 512 * i_, key_ = p_ >> 3, ch_ = p_ & 7; const int kr_ = min((srA_) + (key_ >> 6), 31); \
            pre[i_] = *(const u32x4*)(PR + (size_t)(b * 2048 + kr_ * 64 + (key_ & 63)) * NPR + C_K + h * 64 + ch_ * 8); } } while (0)
#define AW_VPREF(srA_, lo_, hi_) do { _Pragma("unroll") for (int i_ = (lo_); i_ < (hi_); ++i_) { const int p_ = tv + 512 * i_, vc_ = ((p_ >> 8) << 2) + (p_ & 3), dim_ = (p_ >> 2) & 63; \
            pre[i_] = *(const u32x4*)(VT + (size_t)(b * 256 + h * 64 + dim_) * VT_LD + 256 + (srA_) * 64 + vc_ * 8); } } while (0)
        AW_KPREF(min(max(16 * hf - 4, 0), 24));
#pragma nounroll
        for (int it = 0; it < 8; ++it) {
            const int r0 = 16 * hf + 2 * it, srA = min(max(r0 - 4, 0), 24);
            const int ln = lane_id_fresh(); const int qi = ln & 15, g = ln >> 4; tv = wave * 64 + ln;
            const int xk0 = 8 * (qi >> 2) + (qi & 3);
            const int r = r0 + (wave >> 2), j = wave & 3, sr = min(max(r - 4, 0), 24), roff = sr - srA;
            const int band0 = min(max(16 * j - 8, 0), 32);
            __syncthreads();
#pragma unroll
            for (int i = 0; i < 9; ++i) { const int p = tv + 512 * i, key = p >> 3, ch = p & 7; *(LAS u32x4*)(lb + AW_WIN + key * 128 + ((ch ^ aw_swzk(key)) << 4)) = pre[i]; }
            const int qrow = b * 2048 + r * 64 + 16 * j + qi;
            const bf16* qp = PR + (size_t)qrow * NPR + C_Q + h * 64 + 8 * g;
            const bf16x8 q0 = *(const bf16x8*)qp, q1 = *(const bf16x8*)(qp + 32);
            int kwa[2][2], kca[2][2];
#pragma unroll
            for (int t = 0; t < 2; ++t) { const int kw = roff * 64 + band0 + xk0 + 4 * t, swt = aw_swzk(kw), kc0 = xk0 + 4 * t, swc = aw_swzk(kc0);
                kwa[t][0] = AW_WIN + kw * 128 + ((g ^ swt) << 4); kwa[t][1] = AW_WIN + kw * 128 + (((g + 4) ^ swt) << 4);
                kca[t][0] = AW_CK + kc0 * 128 + ((g ^ swc) << 4); kca[t][1] = AW_CK + kc0 * 128 + (((g + 4) ^ swc) << 4); }
            f32x4 S[16][2];
#pragma unroll
            for (int cc = 0; cc < 16; ++cc) {
                const int c = (cc + 8) & 15;
                if (cc == 8) { __syncthreads(); }
#pragma unroll
                for (int t = 0; t < 2; ++t) {
                    const bf16x8 k0 = *(const LAS bf16x8*)(lb + ((c < 8) ? kwa[t][0] + c * 8192 : kca[t][0] + (c - 8) * 4096)), k1 = *(const LAS bf16x8*)(lb + ((c < 8) ? kwa[t][1] + c * 8192 : kca[t][1] + (c - 8) * 4096));
                    const f32x4 z = (f32x4){0.f, 0.f, 0.f, 0.f};
                    S[c][t] = __builtin_amdgcn_mfma_f32_16x16x32_bf16(k0, q0, z, 0, 0, 0); S[c][t] = __builtin_amdgcn_mfma_f32_16x16x32_bf16(k1, q1, S[c][t], 0, 0, 0);
                }
                if ((cc & 3) == 3) __builtin_amdgcn_sched_barrier(0);
            }
            AW_VPREF(srA, 0, 5);
            float mx = -3.0e38f, mxc = -3.0e38f;
            { const int cq = 16 * j + qi, scq = min(max(cq - 8, 0), 48);
              int bidx[8]; bool vld[8];
#pragma unroll
              for (int te = 0; te < 8; ++te) { const int kc = band0 + 8 * g + te; vld[te] = (kc >= scq) && (kc < scq + 16); bidx[te] = h * 465 + (sr - r + 7) * 31 + min(max(kc - cq + 15, 0), 30); }
#pragma unroll
              for (int c = 0; c < 16; ++c) {
                  if (c < 8) {
                      float rb[8];
#pragma unroll
                      for (int te = 0; te < 8; ++te) rb[te] = *(const volatile LAS float*)(rpbL + bidx[te] + c * 31);
#pragma unroll
                      for (int t = 0; t < 2; ++t)
#pragma unroll
                          for (int e = 0; e < 4; ++e) { const float sv = vld[t * 4 + e] ? __builtin_fmaf(S[c][t][e], 0.125f * 1.44269504f, rb[t * 4 + e]) : -3.0e38f; S[c][t][e] = sv; mx = fmaxf(mx, sv); }
                  } else {
#pragma unroll
                      for (int t = 0; t < 2; ++t)
#pragma unroll
                          for (int e = 0; e < 4; ++e) mxc = fmaxf(mxc, S[c][t][e]);
                  }
              } }
            mx = fmaxf(mx, mxc * (0.125f * 1.44269504f));
            mx = fmaxf(mx, __shfl_xor(mx, 16)); mx = fmaxf(mx, __shfl_xor(mx, 32));
            float sum = 0.f;
            bf16x8 pf[16];
#pragma unroll
            for (int c = 0; c < 16; ++c) {
                float pv[8];
#pragma unroll
                for (int t = 0; t < 2; ++t)
#pragma unroll
                    for (int e = 0; e < 4; ++e) { pv[t * 4 + e] = __builtin_amdgcn_exp2f(c < 8 ? S[c][t][e] - mx : __builtin_fmaf(S[c][t][e], 0.125f * 1.44269504f, -mx)); sum += pv[t * 4 + e]; }
                u32x4 w; w.x = pack2(pv[0], pv[1]); w.y = pack2(pv[2], pv[3]); w.z = pack2(pv[4], pv[5]); w.w = pack2(pv[6], pv[7]);
                pf[c] = __builtin_bit_cast(bf16x8, w);
            }
            sum += __shfl_xor(sum, 16); sum += __shfl_xor(sum, 32);
            AW_VPREF(srA, 5, 9);
            __syncthreads();
#pragma unroll
            for (int i = 0; i < 9; ++i) { const int p = tv + 512 * i, vc = ((p >> 8) << 2) + (p & 3), dim = (p >> 2) & 63; *(LAS u32x4*)(lb + AW_WIN + vc * 1024 + dim * 16) = pre[i]; }
            if (it + 1 < 8) AW_KPREF(min(max(r0 + 2 - 4, 0), 24));
            int vwa[4], vca[4];
#pragma unroll
            for (int dt = 0; dt < 4; ++dt) { const int dim = 16 * dt + qi; vwa[dt] = AW_WIN + (roff * 8 + (band0 >> 3) + g) * 1024 + dim * 16; vca[dt] = AW_CV + dim * 64 + ((g ^ ((dim >> 2) & 3)) << 4); }
            f32x4 Oa[4];
#pragma unroll
            for (int dt = 0; dt < 4; ++dt) Oa[dt] = (f32x4){0.f, 0.f, 0.f, 0.f};
#pragma unroll
            for (int cc = 0; cc < 16; ++cc) {
                const int c = (cc + 8) & 15;
                if (cc == 8) { __syncthreads(); }
#pragma unroll
                for (int dt = 0; dt < 4; ++dt) Oa[dt] = __builtin_amdgcn_mfma_f32_16x16x32_bf16(*(const LAS bf16x8*)(lb + ((c < 8) ? vwa[dt] + c * 8192 : vca[dt] + (c - 8) * 4096)), pf[c], Oa[dt], 0, 0, 0);
                if ((cc & 3) == 3) __builtin_amdgcn_sched_barrier(0);
            }
            const float inv = 1.0f / sum;
            bf16* op = O + (size_t)qrow * DM + 512 + h * 64 + 4 * g;
#pragma unroll
            for (int dt = 0; dt < 4; ++dt) { u32x2 w; w.x = pack2(Oa[dt][0] * inv, Oa[dt][1] * inv); w.y = pack2(Oa[dt][2] * inv, Oa[dt][3] * inv); *(u32x2*)(op + 16 * dt) = w; }
        }
#undef AW_KPREF
#undef AW_VPREF
        if (L == 0) {
            const int ln = lane_id_fresh(); const int qi = ln & 15, g = ln >> 4; const int xk0 = 8 * (qi >> 2) + (qi & 3);
            const int qrow = ML + b * 256 + 16 * (hf * 8 + wave) + qi;
            const bf16* qp = PR + (size_t)qrow * NPR + C_Q + h * 64 + 8 * g;
            const bf16x8 q0 = *(const bf16x8*)qp, q1 = *(const bf16x8*)(qp + 32);
            int kca[2][2], vca[4];
#pragma unroll
            for (int t = 0; t < 2; ++t) { const int kc0 = xk0 + 4 * t, swc = aw_swzk(kc0); kca[t][0] = AW_CK + kc0 * 128 + ((g ^ swc) << 4); kca[t][1] = AW_CK + kc0 * 128 + (((g + 4) ^ swc) << 4); }
#pragma unroll
            for (int dt = 0; dt < 4; ++dt) { const int dim = 16 * dt + qi; vca[dt] = AW_CV + dim * 64 + ((g ^ ((dim >> 2) & 3)) << 4); }
            f32x4 S[8][2]; float mx = -3.0e38f;
#pragma unroll
            for (int c = 0; c < 8; ++c)
#pragma unroll
                for (int t = 0; t < 2; ++t) {
                    const bf16x8 k0 = *(const LAS bf16x8*)(lb + kca[t][0] + c * 4096), k1 = *(const LAS bf16x8*)(lb + kca[t][1] + c * 4096);
                    const f32x4 z = (f32x4){0.f, 0.f, 0.f, 0.f};
                    S[c][t] = __builtin_amdgcn_mfma_f32_16x16x32_bf16(k0, q0, z, 0, 0, 0); S[c][t] = __builtin_amdgcn_mfma_f32_16x16x32_bf16(k1, q1, S[c][t], 0, 0, 0);
#pragma unroll
                    for (int e = 0; e < 4; ++e) { S[c][t][e] *= (0.125f * 1.44269504f); mx = fmaxf(mx, S[c][t][e]); } }
            mx = fmaxf(mx, __shfl_xor(mx, 16)); mx = fmaxf(mx, __shfl_xor(mx, 32));
            float sum = 0.f; f32x4 Oa[4];
#pragma unroll
            for (int dt = 0; dt < 4; ++dt) Oa[dt] = (f32x4){0.f, 0.f, 0.f, 0.f};
#pragma unroll
            for (int c = 0; c < 8; ++c) { float pv[8];
#pragma unroll
                for (int t = 0; t < 2; ++t)
#pragma unroll
                    for (int e = 0; e < 4; ++e) { pv[t * 4 + e] = __builtin_amdgcn_exp2f(S[c][t][e] - mx); sum += pv[t * 4 + e]; }
                u32x4 w; w.x = pack2(pv[0], pv[1]); w.y = pack2(pv[2], pv[3]); w.z = pack2(pv[4], pv[5]); w.w = pack2(pv[6], pv[7]);
                const bf16x8 pfc = __builtin_bit_cast(bf16x8, w);
#pragma unroll
                for (int dt = 0; dt < 4; ++dt) Oa[dt] = __builtin_amdgcn_mfma_f32_16x16x32_bf16(*(const LAS bf16x8*)(lb + vca[dt] + c * 4096), pfc, Oa[dt], 0, 0, 0); }
            sum += __shfl_xor(sum, 16); sum += __shfl_xor(sum, 32);
            const float inv = 1.0f / sum;
            bf16* op = O + (size_t)qrow * DM + 512 + h * 64 + 4 * g;
#pragma unroll
            for (int dt = 0; dt < 4; ++dt) { u32x2 w; w.x = pack2(Oa[dt][0] * inv, Oa[dt][1] * inv); w.y = pack2(Oa[dt][2] * inv, Oa[dt][3] * inv); *(u32x2*)(op + 16 * dt) = w; }
        }
    }
    __syncthreads();
}
constexpr int PC_P_OFF = 48 * 256 * 4, PC_P_LD = 528;
template <int L>
__device__ __forceinline__ void poolconv_mfma(const Frame& F, int nrows) {
    PHASE_IDS
    const bf16* PR = (const bf16*)(F.ws + WS_PRB);
    bf16* O = (bf16*)(F.ws + WS_HB);
    LAS float* ut = (LAS float*)F.lds;
    LAS unsigned char* pl = F.lds + PC_P_OFF;
    const float* pw = inptr(F, I_POOLW) + (size_t)L * 4 * 64 * 64; const float* psc = inptr(F, I_POOLS) + L * 256; const float* cw = inptr(F, I_CONVW) + (size_t)L * 3 * 256;
    const int lq = lane & 15, g4 = lane >> 4, grp = wave & 3, tt = wave >> 2;
    bf16x8 Wf[4][2]; f32x4 scl[4];
#pragma unroll
    for (int nt = 0; nt < 4; ++nt) {
#pragma unroll
        for (int kk = 0; kk < 2; ++kk) { float w8[8];
#pragma unroll
            for (int e = 0; e < 8; ++e) w8[e] = pw[(grp * 64 + 32 * kk + 8 * g4 + e) * 64 + 16 * nt + lq];
            u32x4 pk; pk.x = pack2(w8[0], w8[1]); pk.y = pack2(w8[2], w8[3]); pk.z = pack2(w8[4], w8[5]); pk.w = pack2(w8[6], w8[7]); Wf[nt][kk] = __builtin_bit_cast(bf16x8, pk); }
        scl[nt] = *(const f32x4*)(psc + grp * 64 + 16 * nt + 4 * g4);
    }
    const int cp = tid & 127, seg = tid >> 7;
    const float cw00 = cw[2 * cp], cw01 = cw[256 + 2 * cp], cw02 = cw[512 + 2 * cp], cw10 = cw[2 * cp + 1], cw11 = cw[256 + 2 * cp + 1], cw12 = cw[512 + 2 * cp + 1];
    unsigned uw[12], hr[10], cr[10], bg[8];
#define PC_GEOM(item_) const int m0 = (item_) * 32; const bool lat = m0 < ML; const int Ls = lat ? 2048 : 256; const int seq0 = lat ? (m0 & ~2047) : ML + ((m0 - ML) & ~255); const int t0 = m0 - seq0;
#define PC_LOAD(item_) do { PC_GEOM(item_) \
        _Pragma("unroll") for (int it = 0; it < 12; ++it) { const int rr = it * 4 + seg, t = t0 - 8 + rr; uw[it] = 0u; if (t >= 0 && t < Ls) uw[it] = *(const unsigned*)(PR + (size_t)(seq0 + t) * NPR + C_POOL + 2 * cp); } \
        const int tb = t0 + 8 * seg - 1; \
        _Pragma("unroll") for (int k = 0; k < 10; ++k) { const int t = tb + k; const bool ok = (t >= 0) && (t < Ls); const bf16* pp = PR + (size_t)(seq0 + (ok ? t : 0)) * NPR + 2 * cp; \
            hr[k] = ok ? *(const unsigned*)(pp + C_CONVH) : 0u; cr[k] = ok ? *(const unsigned*)(pp + C_CONVC) : 0u; if (k >= 1 && k <= 8) bg[k - 1] = *(const unsigned*)(pp + C_CONVB); } } while (0)
    if (F.bid < nrows / 32) PC_LOAD(F.bid);
    for (int item = F.bid; item < nrows / 32; item += F.G) {
        PC_GEOM(item)
        (void)lat;
        __syncthreads();
#pragma unroll
        for (int it = 0; it < 12; ++it) { const int rr = it * 4 + seg; ut[rr * 256 + 2 * cp] = bflo(uw[it]); ut[rr * 256 + 2 * cp + 1] = bfhi(uw[it]); }
        { float p0[10], p1[10];
#pragma unroll
          for (int k = 0; k < 10; ++k) { p0[k] = bflo(hr[k]) * bflo(cr[k]); p1[k] = bfhi(hr[k]) * bfhi(cr[k]); }
#pragma unroll
          for (int k = 0; k < 8; ++k) { const float y0 = bflo(bg[k]) * (cw00 * p0[k] + cw01 * p0[k + 1] + cw02 * p0[k + 2]), y1 = bfhi(bg[k]) * (cw10 * p1[k] + cw11 * p1[k + 1] + cw12 * p1[k + 2]);
              *(unsigned*)(O + (size_t)(m0 + 8 * seg + k) * DM + 256 + 2 * cp) = pack2(y0, y1); } }
        if (item + F.G < nrows / 32) PC_LOAD(item + F.G);
        __syncthreads();
        { const int c = tid & 255, sg = tid >> 8, gg = c >> 6, hw = 1 << gg;
          int t = t0 + 16 * sg; float S = 0.f;
          for (int q = -hw; q < hw; ++q) S += ut[(16 * sg + 8 + q) * 256 + c];
#pragma unroll 4
          for (int i = 0; i < 16; ++i, ++t) { const int rr = 16 * sg + i + 8;
              const int cnt = min(t + hw, Ls) - max(t - hw, 0);
              *(LAS bf16*)(pl + (16 * sg + i) * PC_P_LD + c * 2) = f2bf(S / (float)cnt - ut[rr * 256 + c]);
              S += ut[(rr + hw) * 256 + c] - ut[(rr - hw) * 256 + c]; } }
        __syncthreads();
        { const bf16x8 B0 = *(const LAS bf16x8*)(pl + (16 * tt + lq) * PC_P_LD + (grp * 64 + 8 * g4) * 2), B1 = *(const LAS bf16x8*)(pl + (16 * tt + lq) * PC_P_LD + (grp * 64 + 32 + 8 * g4) * 2);
          bf16* op = O + (size_t)(m0 + 16 * tt + lq) * DM + grp * 64 + 4 * g4;
#pragma unroll
          for (int nt = 0; nt < 4; ++nt) { f32x4 D = (f32x4){0.f, 0.f, 0.f, 0.f};
              D = __builtin_amdgcn_mfma_f32_16x16x32_bf16(Wf[nt][0], B0, D, 0, 0, 0); D = __builtin_amdgcn_mfma_f32_16x16x32_bf16(Wf[nt][1], B1, D, 0, 0, 0);
              D *= scl[nt]; u32x2 w; w.x = pack2(D[0], D[1]); w.y = pack2(D[2], D[3]); *(u32x2*)(op + 16 * nt) = w; } }
    }
    __syncthreads();
#undef PC_LOAD
#undef PC_GEOM
}
template <int L>
__device__ __forceinline__ void ssd_combine(const Frame& F, const bf16* Yd, int nrows) {
    PHASE_IDS
    const bf16* PR = (const bf16*)(F.ws + WS_PRB);
    bf16* O = (bf16*)(F.ws + WS_HB);
    const f32x4 ng = *(const f32x4*)(inptr(F, I_SNG) + L * 256 + lane * 4);
    for (int m = F.bid * 8 + wave; m < nrows; m += F.G * 8) {
        const u32x2 y0w = *(const u32x2*)(Yd + (size_t)m * 256 + lane * 4), y1w = *(const u32x2*)(Yd + ((size_t)MT + m) * 256 + lane * 4);
        const f32x4 y0 = (f32x4){bflo(y0w.x), bfhi(y0w.x), bflo(y0w.y), bfhi(y0w.y)}, y1 = (f32x4){bflo(y1w.x), bfhi(y1w.x), bflo(y1w.y), bfhi(y1w.y)};
        const u32x2 zw = *(const u32x2*)(PR + (size_t)m * NPR + C_Z + lane * 4);
        f32x4 v; v[0] = (y0[0] + y1[0]) * silu_f(bflo(zw.x)); v[1] = (y0[1] + y1[1]) * silu_f(bfhi(zw.x)); v[2] = (y0[2] + y1[2]) * silu_f(bflo(zw.y)); v[3] = (y0[3] + y1[3]) * silu_f(bfhi(zw.y));
        const float ss = wave_sum(v[0] * v[0] + v[1] * v[1] + v[2] * v[2] + v[3] * v[3]);
        const float rstd = rsqrtf(ss * (1.0f / 256.0f) + EPS);
        u32x2 w; w.x = pack2(v[0] * rstd * ng[0], v[1] * rstd * ng[1]); w.y = pack2(v[2] * rstd * ng[2], v[3] * rstd * ng[3]);
        *(u32x2*)(O + (size_t)m * DM + 768 + lane * 4) = w;
    }
}
__device__ __forceinline__ void final_phase(const Frame& F) {
    PHASE_IDS
    const bf16* XR = (const bf16*)(F.ws + WS_XR);
    const bf16* Y = (const bf16*)F.out;
    const float* mod = (const float*)(F.ws + WS_MOD) + (size_t)1 * 33 * 6144 + 5 * 1024;
    const float* gfin = inptr(F, I_GFINAL);
    const int per = (ML + F.G * 8 - 1) / (F.G * 8), mbeg = (F.bid * 8 + wave) * per, mend = min(mbeg + per, ML);
    u32x2 xw[4], ya[4], yb[4], xwn[4], yan[4], ybn[4];
    f32x4 gfv[4];
#pragma unroll
    for (int j = 0; j < 4; ++j) gfv[j] = *(const f32x4*)(gfin + j * 256 + lane * 4);
#define FP_LOAD(m, XW, YA, YB) do { _Pragma("unroll") for (int j = 0; j < 4; ++j) { const int e = j * 256 + lane * 4; XW[j] = *(const GAS u32x2*)((const GAS bf16*)XR + (size_t)(m) * DM + e); \
        YA[j] = *(const GAS u32x2*)((const GAS bf16*)Y + (size_t)(2 * (m)) * DM + e); YB[j] = *(const GAS u32x2*)((const GAS bf16*)Y + (size_t)(2 * (m) + 1) * DM + e); } } while (0)
    if (mbeg < mend) FP_LOAD(mbeg, xw, ya, yb);
    for (int m = mbeg; m < mend; ++m) {
        if (m + 1 < mend) FP_LOAD(m + 1, xwn, yan, ybn);
        const float* grow = mod + (size_t)(m >> 11) * 6144;
        f32x4 v[4]; float ss = 0.f;
#pragma unroll
        for (int j = 0; j < 4; ++j) { const int e = j * 256 + lane * 4; const f32x4 g = *(const f32x4*)(grow + e);
            v[j][0] = bflo(xw[j].x) + g[0] * (bflo(ya[j].x) + bflo(yb[j].x)); v[j][1] = bfhi(xw[j].x) + g[1] * (bfhi(ya[j].x) + bfhi(yb[j].x));
            v[j][2] = bflo(xw[j].y) + g[2] * (bflo(ya[j].y) + bflo(yb[j].y)); v[j][3] = bfhi(xw[j].y) + g[3] * (bfhi(ya[j].y) + bfhi(yb[j].y));
            ss += v[j][0] * v[j][0] + v[j][1] * v[j][1] + v[j][2] * v[j][2] + v[j][3] * v[j][3]; }
        ss = wave_sum(ss);
        const float rstd = rsqrtf(ss * (1.0f / DM) + EPS);
#pragma unroll
        for (int j = 0; j < 4; ++j) { const int e = j * 256 + lane * 4; *(f32x4*)(F.out + (size_t)m * DM + e) = v[j] * rstd * gfv[j]; }
#pragma unroll
        for (int j = 0; j < 4; ++j) { xw[j] = xwn[j]; ya[j] = yan[j]; yb[j] = ybn[j]; }
    }
#undef FP_LOAD
}

constexpr int N_PHASES = 19;
#ifndef DUP
#define DUP 0
#endif
__global__ void __launch_bounds__(512, 2) fwd_kernel(Args args) {
    extern __shared__ __attribute__((aligned(16))) unsigned char lds_raw[];
    Frame F;
    F.lds = (LAS unsigned char*)lds_raw;
    F.G = gridDim.x; F.bid = blockIdx.x; F.wv = __builtin_amdgcn_readfirstlane(threadIdx.x >> 6);
    F.out = args.out; F.ws = args.ws;
    volatile LAS unsigned* ctlw = (volatile LAS unsigned*)(F.lds + LDSCTL_OFF);
    if (threadIdx.x < 4) ctlw[threadIdx.x] = 0u;
    { volatile LAS unsigned long long* tbl = (volatile LAS unsigned long long*)(F.lds + LDSCTL_OFF + 16);
#pragma unroll
      for (int i = 0; i < 26; ++i) if (threadIdx.x == 64 + i) tbl[i] = (unsigned long long)args.in[i]; }
    __syncthreads();
    const int lo = args.ph_lo, hi = args.ph_hi;
    const bool multi = (hi - lo) > 1;
    XcdBarrier bar; bar.bar = (unsigned*)(F.ws + WS_CTL) + CW_BAR; bar.x = 0; bar.st = ctlw;
    if (multi) bar = xcd_barrier_post((unsigned*)(F.ws + WS_CTL) + CW_BAR, ctlw);
#define IN(k) (lo <= (k) && (k) < hi)
#define SEAM(k) do { if (IN((k) + 1)) xcd_barrier(bar, F.wv); } while (0)
    unsigned char* wb = F.ws + WS_WB;
    bf16* HB = (bf16*)(F.ws + WS_HB); bf16* PRB = (bf16*)(F.ws + WS_PRB);
    const float* MOD = (const float*)(F.ws + WS_MOD);
    bf16* Yd = (bf16*)F.out;

    if (IN(0)) { p0_prologue(F); SEAM(0); }
    if (IN(1)) { conv_tiles(F, 0, 704, 0, 0, F.bid, F.G); norm_phase<0, 6, false, false>(F, MT, nullptr, nullptr); SEAM(1); }
    if (IN(2)) { pg8::DenseOrderT<true> S; S.init(MT, NPR, F.G, F.bid); pg8::EpiInProjI8 E{PRB, (bf16*)(F.ws + WS_VT), (const float*)(F.ws + WS_RS), (const float*)(F.ws + WS_CSIN)};
        pg8::gemm_phase<pg8::EpiInProjI8, pg8::DenseOrderT<true>, 2>(F.lds, F.wv, HB, (const bf16*)(wb + WB_IN), DM / 2, S, E);
        { int w, nw; if (tail_worker(F, (MT / 256) * (NPR / 256), w, nw)) conv_tiles(F, 1408, 256, 1920, 1408, w, nw); }
        SEAM(2); }
    if (IN(3)) { ssd_scan_mfma<0>(F, Yd); attn_phase<0>(F); poolconv_mfma<0>(F, MT); SEAM(3); }
    if (IN(4)) { ssd_combine<0>(F, Yd, MT); SEAM(4); }
    if (IN(5)) { pg8::DenseOrder S; S.init(MT, DM, F.G, F.bid); pg8::EpiResid<true> E{(bf16*)(F.ws + WS_XR), inptr(F, I_X), inptr(F, I_CTX), MOD + 2 * 1024};
        pg8::gemm_phase(F.lds, F.wv, HB, (const bf16*)(wb + WB_OUT), DM, S, E);
        { int w, nw; if (tail_worker(F, (MT / 256) * (DM / 256), w, nw)) conv_tiles(F, 3328, 704, 704, 704, w, nw); }
        SEAM(5); }
    if (IN(6)) { norm_phase<0, 5, true, false>(F, MT, nullptr, nullptr); SEAM(6); }
    if (IN(7)) { pg8::DenseOrderT<true> S; S.init(MT, 2 * DFF, F.G, F.bid); pg8::EpiSwigluI8 E{PRB, DFF, (const float*)(F.ws + WS_RS), (const float*)(F.ws + WS_CS), DFF};
        pg8::gemm_phase<pg8::EpiSwigluI8, pg8::DenseOrderT<true>, 2>(F.lds, F.wv, HB, (const bf16*)(wb + WB_GU), DM / 2, S, E);
        { int w, nw; if (tail_worker(F, (MT / 256) * (2 * DFF / 256), w, nw)) conv_tiles(F, 1664, 256, 0, 0, w, nw); }
        SEAM(7); }
    if (IN(8)) { pg8::DenseOrder S; S.init(MT, DM, F.G, F.bid); pg8::EpiResid<false> E{(bf16*)(F.ws + WS_XR), nullptr, nullptr, MOD + 5 * 1024};
        pg8::gemm_phase(F.lds, F.wv, PRB, (const bf16*)(wb + WB_DOWN), DFF, S, E);
        { int w, nw; if (tail_worker(F, (MT / 256) * (DM / 256), w, nw)) conv_tiles(F, 4032, 8448, 0, 0, w, nw); }
        SEAM(8); }
    if (IN(9)) { norm_phase<1, 6, true, false>(F, MT, nullptr, nullptr); SEAM(9); }
    if (IN(10)) { pg8::InProjL1OrderT<true> S; S.init(F.G, F.bid); pg8::EpiInProjI8 E{PRB, (bf16*)(F.ws + WS_VT), (const float*)(F.ws + WS_RS), (const float*)(F.ws + WS_CSIN) + NPR};
        pg8::gemm_phase<pg8::EpiInProjI8, pg8::InProjL1OrderT<true>, 2>(F.lds, F.wv, HB, (const bf16*)(wb + WB_IN + WB_IN_SZ), DM / 2, S, E); SEAM(10); }
    if (IN(11)) { ssd_scan_mfma<1>(F, Yd); attn_phase<1>(F); poolconv_mfma<1>(F, ML); SEAM(11); }
    if (IN(12)) { ssd_combine<1>(F, Yd, ML); SEAM(12); }
    if (IN(13)) { pg8::DenseOrder S; S.init(ML, DM, F.G, F.bid); pg8::EpiResid<false> E{(bf16*)(F.ws + WS_XR), nullptr, nullptr, MOD + 33 * 6144 + 2 * 1024};
        pg8::gemm_phase(F.lds, F.wv, HB, (const bf16*)(wb + WB_OUT + WB_OUT_SZ), DM, S, E); SEAM(13); }
    if (IN(14)) { norm_phase<1, 2, true, false>(F, ML, nullptr, nullptr); SEAM(14); }
    if (IN(16)) { pg8::MoeOrder<true> S; S.init((const unsigned*)(F.ws + WS_CTL) + CW_CNT, (const int*)(F.ws + WS_LISTE), WB_MGU_SZ, 2 * DFE, F.G, F.bid); pg8::EpiSwigluF8 E{F.ws + WS_PRB};
        pg8::gemm_phase<pg8::EpiSwigluF8, pg8::MoeOrder<true>, 1>(F.lds, F.wv, HB, (const bf16*)(wb + WB_MGU), DM / 2, S, E); SEAM(16); }
    if (IN(17)) { pg8::MoeOrder<false, true> S; S.init((const unsigned*)(F.ws + WS_CTL) + CW_CNT, (const int*)(F.ws + WS_LISTE), WB_MDOWN_SZ, DM, F.G, F.bid);
        pg8::EpiMoeOut E{(bf16*)F.out, (const int*)(F.ws + WS_LISTE), (const float*)(F.ws + WS_ROUTE) + 4 * ML};
        pg8::gemm_phase<pg8::EpiMoeOut, pg8::MoeOrder<false, true>, 1>(F.lds, F.wv, PRB, (const bf16*)(wb + WB_MDOWN), DFEP / 2, S, E); SEAM(17); }
    if (IN(18)) { final_phase(F); }
#undef IN
#undef SEAM
}

#ifndef N_LAUNCHES
#define N_LAUNCHES 1
#endif
extern "C" void kernel_launch(void* const* d_in, const int* in_sizes, int n_in, void* d_out, int out_size, void* d_ws, size_t ws_size, hipStream_t stream) {
    static int grid = 0;
    if (grid == 0) {
        if (n_in != 26 || out_size != ML * DM || ws_size < WS_END) { fprintf(stderr, "kernel_launch: unexpected shapes: n_in %d out %d ws %zu\n", n_in, out_size, ws_size); grid = -1; return; }
        int dev = 0, cus = 0, per_cu = 0;
        if (hipGetDevice(&dev) != hipSuccess || hipDeviceGetAttribute(&cus, hipDeviceAttributeMultiprocessorCount, dev) != hipSuccess) { grid = -1; return; }
        if (hipFuncSetAttribute((const void*)fwd_kernel, hipFuncAttributeMaxDynamicSharedMemorySize, LDS_BYTES) != hipSuccess) { fprintf(stderr, "kernel_launch: hipFuncSetAttribute failed\n"); grid = -1; return; }
        if (hipOccupancyMaxActiveBlocksPerMultiprocessor(&per_cu, (const void*)fwd_kernel, 512, LDS_BYTES) != hipSuccess || per_cu < 1) { fprintf(stderr, "kernel_launch: occupancy query says %d\n", per_cu); (void)hipGetLastError(); per_cu = 1; }
        grid = cus;
    }
    if (grid < 0) return;
    (void)hipMemsetAsync((char*)d_ws + WS_CTL, 0, 64 * 1024, stream);
    Args a{};
    for (int i = 0; i < 26; ++i) a.in[i] = (const float*)d_in[i];
    a.out = (float*)d_out; a.ws = (unsigned char*)d_ws;
    if (N_LAUNCHES == 1) { a.ph_lo = 0; a.ph_hi = N_PHASES; hipLaunchKernelGGL(fwd_kernel, dim3(grid), dim3(512), LDS_BYTES, stream, a); }
    else { for (int p = 0; p < N_PHASES; ++p) { a.ph_lo = p; a.ph_hi = p + 1; hipLaunchKernelGGL(fwd_kernel, dim3(grid), dim3(512), LDS_BYTES, stream, a); } }
}
```

```cpp
#include <hip/hip_runtime.h>
#include <cstdio>
#include <cstdint>

#define LAS __attribute__((address_space(3)))
#define GAS __attribute__((address_space(1)))
typedef unsigned short bf16;
typedef short bf16x8 __attribute__((ext_vector_type(8)));
typedef float f32x4 __attribute__((ext_vector_type(4)));
typedef unsigned u32x4 __attribute__((ext_vector_type(4)));
typedef unsigned u32x2 __attribute__((ext_vector_type(2)));
typedef int i32x4 __attribute__((ext_vector_type(4)));
typedef int i32x8 __attribute__((ext_vector_type(8)));

constexpr int DM = 1024, NB = 32, SEQ = 2048, CTXL = 256, GRIDW = 64;
constexpr int ML = NB * SEQ;
constexpr int MC = NB * CTXL;
constexpr int MT = ML + MC;
constexpr int NPR = 2816;
constexpr int DIN = 2824;
constexpr int DFF = 2816, DFE = 1408, NEXP = 8;
constexpr int MOE_ROWS = 2 * ML + NEXP * 256;
constexpr float EPS = 1e-6f;
constexpr int C_POOL = 0, C_CONVH = 256, C_CONVB = 512, C_CONVC = 768, C_Q = 1024, C_K = 1280, C_V = 1536, C_Z = 1792, C_XBC = 2048;

constexpr size_t MiB = 1u << 20;
constexpr size_t WS_CTL = 0, CTL_BYTES = 1 * MiB;
constexpr size_t WS_MOD = 1 * MiB;
constexpr size_t WS_ROUTE = 3 * MiB;
constexpr size_t WS_ROWTOK = 5 * MiB;
constexpr size_t WS_WB = 8 * MiB;
constexpr size_t WS_XR = 106 * MiB;
constexpr size_t WS_HB = 394 * MiB;
constexpr size_t WS_PRB = 538 * MiB;
constexpr size_t WS_DT = 934 * MiB;
constexpr size_t WS_VT = 937 * MiB;
constexpr int VT_LD = 2304;
constexpr size_t WS_LISTE = 976 * MiB;
constexpr size_t WS_END = 1024 * MiB;
constexpr size_t WB_IN = 0, WB_IN_SZ = (size_t)NPR * DM * 2;
constexpr size_t WB_OUT = 2 * WB_IN_SZ, WB_OUT_SZ = (size_t)DM * DM * 2;
constexpr size_t WB_GU = WB_OUT + 2 * WB_OUT_SZ, WB_GU_SZ = (size_t)2 * DFF * DM * 2;
constexpr size_t WS_RS = WS_ROUTE;
constexpr size_t WS_CS = WS_ROWTOK;
constexpr size_t WS_CSIN = 6 * MiB;
constexpr size_t WB_DOWN = WB_GU + WB_GU_SZ, WB_DOWN_SZ = (size_t)DM * DFF * 2;
constexpr int DFEP = 1536;
constexpr float W8S = 32.f, H8S = 4.f;
constexpr size_t WB_MGU = WB_DOWN + WB_DOWN_SZ, WB_MGU_SZ = (size_t)2 * DFE * DM;
constexpr size_t WB_MDOWN = WB_MGU + NEXP * WB_MGU_SZ, WB_MDOWN_SZ = (size_t)DM * DFEP;
static_assert(WB_MDOWN + NEXP * WB_MDOWN_SZ <= 98 * MiB, "weights fit");
constexpr int CW_CNT = 512;
constexpr int CW_POFF = 128;
constexpr int CW_BAR = 4096;

constexpr int LDS_BYTES = 147456;
constexpr int LDSCTL_OFF = LDS_BYTES - 256;

__device__ __forceinline__ float bf2f(unsigned v) { return __uint_as_float(v << 16); }
__device__ __forceinline__ float bflo(unsigned w) { return __uint_as_float(w << 16); }
__device__ __forceinline__ float bfhi(unsigned w) { return __uint_as_float(w & 0xFFFF0000u); }
__device__ __forceinline__ unsigned pack2(float lo, float hi) { unsigned r; asm volatile("v_cvt_pk_bf16_f32 %0, %1, %2" : "=v"(r) : "v"(lo), "v"(hi)); return r; }
typedef __bf16 hwbf16x2 __attribute__((ext_vector_type(2)));
typedef float f32x2_ __attribute__((ext_vector_type(2)));
__device__ __forceinline__ unsigned pack2_acc(float lo, float hi) { return __builtin_bit_cast(unsigned, __builtin_convertvector((f32x2_){lo, hi}, hwbf16x2)); }
__device__ __forceinline__ bf16 f2bf(float f) { return (bf16)(pack2(f, 0.f) & 0xFFFFu); }
__device__ __forceinline__ unsigned pack4_fp8(float a, float b, float c, float d) {
    a = fminf(fmaxf(a, -448.f), 448.f); b = fminf(fmaxf(b, -448.f), 448.f); c = fminf(fmaxf(c, -448.f), 448.f); d = fminf(fmaxf(d, -448.f), 448.f);
    int w = 0; w = __builtin_amdgcn_cvt_pk_fp8_f32(a, b, w, false); w = __builtin_amdgcn_cvt_pk_fp8_f32(c, d, w, true); return (unsigned)w;
}
__device__ __forceinline__ float silu_f(float v) { return v * __builtin_amdgcn_rcpf(1.0f + __expf(-v)); }
__device__ __forceinline__ float softplus_f(float v) { return v > 20.f ? v : log1pf(__expf(v)); }
__device__ __forceinline__ float dpp_f(float v, const int ctrl_sel) {
    const int x = __float_as_int(v); int r;
    if (ctrl_sel == 0) r = __builtin_amdgcn_update_dpp(x, x, 0xB1, 0xF, 0xF, false);
    else if (ctrl_sel == 1) r = __builtin_amdgcn_update_dpp(x, x, 0x4E, 0xF, 0xF, false);
    else if (ctrl_sel == 2) r = __builtin_amdgcn_update_dpp(x, x, 0x141, 0xF, 0xF, false);
    else r = __builtin_amdgcn_update_dpp(x, x, 0x140, 0xF, 0xF, false);
    return __int_as_float(r);
}
__device__ __forceinline__ float row8_sum(float v) { v += dpp_f(v, 0); v += dpp_f(v, 1); v += dpp_f(v, 2); return v; }
__device__ __forceinline__ float wave_sum(float v) {
    v = row8_sum(v); v += dpp_f(v, 3);
    const float s0 = __int_as_float(__builtin_amdgcn_readlane(__float_as_int(v), 0)), s1 = __int_as_float(__builtin_amdgcn_readlane(__float_as_int(v), 16)),
                s2 = __int_as_float(__builtin_amdgcn_readlane(__float_as_int(v), 32)), s3 = __int_as_float(__builtin_amdgcn_readlane(__float_as_int(v), 48));
    return (s0 + s1) + (s2 + s3);
}
__device__ __forceinline__ float wave_scan_incl(float v, const int lane) {
#define WS_SHR(c) __int_as_float(__builtin_amdgcn_update_dpp(0, __float_as_int(v), (c), 0xF, 0xF, false))
    v += WS_SHR(0x111); v += WS_SHR(0x112); v += WS_SHR(0x114); v += WS_SHR(0x118);
#undef WS_SHR
    const float t0 = __int_as_float(__builtin_amdgcn_readlane(__float_as_int(v), 15)), t1 = __int_as_float(__builtin_amdgcn_readlane(__float_as_int(v), 31)), t2 = __int_as_float(__builtin_amdgcn_readlane(__float_as_int(v), 47));
    return v + ((lane >= 16 ? t0 : 0.f) + (lane >= 32 ? t1 : 0.f)) + (lane >= 48 ? t2 : 0.f);
}
__device__ __forceinline__ float wave_max_dpp(float v) {
    v = fmaxf(v, dpp_f(v, 0)); v = fmaxf(v, dpp_f(v, 1)); v = fmaxf(v, dpp_f(v, 2)); v = fmaxf(v, dpp_f(v, 3));
    const float s0 = __int_as_float(__builtin_amdgcn_readlane(__float_as_int(v), 0)), s1 = __int_as_float(__builtin_amdgcn_readlane(__float_as_int(v), 16)),
                s2 = __int_as_float(__builtin_amdgcn_readlane(__float_as_int(v), 32)), s3 = __int_as_float(__builtin_amdgcn_readlane(__float_as_int(v), 48));
    return fmaxf(fmaxf(s0, s1), fmaxf(s2, s3));
}
__device__ __forceinline__ unsigned pack4_i8(float a, float b, float c, float d) {
    const int ia = __float2int_rn(a), ib = __float2int_rn(b), ic = __float2int_rn(c), id = __float2int_rn(d);
    return (unsigned)(ia & 255) | ((unsigned)(ib & 255) << 8) | ((unsigned)(ic & 255) << 16) | ((unsigned)(id & 255) << 24);
}
__device__ __forceinline__ float wave_max(float v) {
#pragma unroll
    for (int o = 32; o >= 1; o >>= 1) v = fmaxf(v, __shfl_xor(v, o));
    return v;
}
__device__ __forceinline__ int lane_id_fresh() { int l; asm volatile("v_mbcnt_lo_u32_b32 %0, -1, 0\n\tv_mbcnt_hi_u32_b32 %0, -1, %0" : "=v"(l)); return l; }
__device__ __forceinline__ int modidx_of(int m) { return m < ML ? (m >> 11) : 32; }

#define XB_TMO      128
#define XB_XCNT(j)  (256  + 64 * (j))
#define XB_XSUB(j)  (1280 + 64 * (j))
#define XB_XGEN(j)  (2304 + 64 * (j))
#define XB_TOP      3328
#define XB_TOPGEN   3392
#define XCD_BAR_WORDS 3456
#define XB_SPIN_CAP (1u << 22)
__device__ __forceinline__ unsigned xb_ld(unsigned* p)              { return __hip_atomic_load(p, __ATOMIC_RELAXED, __HIP_MEMORY_SCOPE_AGENT); }
__device__ __forceinline__ unsigned xb_add(unsigned* p, unsigned v) { return __hip_atomic_fetch_add(p, v, __ATOMIC_RELAXED, __HIP_MEMORY_SCOPE_AGENT); }
__device__ __forceinline__ unsigned xb_xcc_id() { return (unsigned)__builtin_amdgcn_s_getreg((3 << 11) | 20) & 0xFu; }
#define XB_SPIN(cond, bar) do { unsigned _sp = 0; while (cond) { __builtin_amdgcn_s_sleep(1); \
    if ((++_sp & 255u) == 0u) { if (xb_ld(&(bar)[XB_TMO])) break; if (_sp > XB_SPIN_CAP) { atomicAdd(&(bar)[XB_TMO], 1u); break; } } } } while (0)
struct XcdBarrier { unsigned* bar; unsigned x; volatile LAS unsigned* st; };
__device__ __forceinline__ XcdBarrier xcd_barrier_post(unsigned* bar, volatile LAS unsigned* st) {
    XcdBarrier b; b.bar = bar; b.x = xb_xcc_id(); b.st = st;
    if (threadIdx.x == 0) (void)xb_add(&bar[XB_XCNT(b.x)], 1u);
    return b;
}
__device__ __forceinline__ void xcd_barrier_complete(unsigned* bar, unsigned x, unsigned& nloc, unsigned& nx) {
    const unsigned G = gridDim.x * gridDim.y * gridDim.z;
    unsigned sum, cnt, mine, sp = 0u;
    for (;;) {
        sum = 0u; cnt = 0u; mine = 0u;
#pragma unroll
        for (unsigned j = 0; j < 16; ++j) { const unsigned c = xb_ld(&bar[XB_XCNT(j)]); sum += c; cnt += (c > 0u) ? 1u : 0u; mine = (j == x) ? c : mine; }
        if (sum == G) break;
        __builtin_amdgcn_s_sleep(1);
        if ((++sp & 255u) == 0u) { if (xb_ld(&bar[XB_TMO])) break; if (sp > XB_SPIN_CAP) { atomicAdd(&bar[XB_TMO], 1u); break; } }
    }
    nloc = mine > 0u ? mine : 1u; nx = cnt > 0u ? cnt : 1u;
}
__device__ __forceinline__ void xcd_barrier(const XcdBarrier& b, const int wv) {
    asm volatile("s_waitcnt vmcnt(0)" ::: "memory");
    __syncthreads();
    if (wv == 0 && lane_id_fresh() == 0) {
        unsigned* bar = b.bar;
        __builtin_amdgcn_s_waitcnt(0);
        unsigned nloc = b.st[0], nx = b.st[1];
        if (nloc == 0u) { xcd_barrier_complete(bar, b.x, nloc, nx); b.st[0] = nloc; b.st[1] = nx; }
        const unsigned old = xb_add(&bar[XB_XSUB(b.x)], 1u);
        const unsigned gen = old / nloc;
        if (old + 1u == (gen + 1u) * nloc) {
            __builtin_amdgcn_fence(__ATOMIC_RELEASE, "agent");
            asm volatile("s_waitcnt vmcnt(0)" ::: "memory");
            const unsigned og = xb_add(&bar[XB_TOP], 1u);
            const unsigned tg = og / nx;
            if (og + 1u == (tg + 1u) * nx) xb_add(&bar[XB_TOPGEN], 1u);
            else XB_SPIN(xb_ld(&bar[XB_TOPGEN]) == tg, bar);
            __builtin_amdgcn_fence(__ATOMIC_ACQUIRE, "agent");
            xb_add(&bar[XB_XGEN(b.x)], 1u);
            asm volatile("s_waitcnt vmcnt(0)" ::: "memory");
        } else {
            XB_SPIN(xb_ld(&bar[XB_XGEN(b.x)]) == gen, bar);
            __builtin_amdgcn_fence(__ATOMIC_ACQUIRE, "agent");
            asm volatile("s_waitcnt vmcnt(0)" ::: "memory");
        }
    }
    __syncthreads();
}

namespace pg8 {
constexpr int BM = 256, BK = 64, HALF = 128, HTB = HALF * BK * 2, STAGE_BYTES = 8 * HTB, NXCD = 8, WGM = 8;
__host__ __device__ __forceinline__ int lds_byte(int r, int c) { const int st = (r >> 4) * 2 + (c >> 5), rr = r & 15, cc = c & 31, ob = rr * 64 + cc * 2; return st * 1024 + (ob ^ (((ob >> 9) & 1) << 5)); }
__host__ __device__ __forceinline__ void stage_rc(int b, int& R, int& C) { const int st = b / 1024, sb = b % 1024, swz = sb ^ (((sb >> 9) & 1) << 5); R = (st >> 1) * 16 + swz / 64; C = (st & 1) * 32 + (swz % 64) / 2; }
__host__ __device__ __forceinline__ int perm32(int rho) { const int n = rho >> 4, i = rho & 15; return 8 * (i >> 2) + 4 * n + (i & 3); }

struct Unit { int pm, pn, ex, ploc; };

__device__ __forceinline__ unsigned magic_of(unsigned d) { return (unsigned)((0x100000000ull + d - 1) / d); }
__device__ __forceinline__ int div_magic(int x, unsigned mg) { return (int)__umulhi((unsigned)x, mg); }
template <bool LIN> struct DenseOrderT {
    static constexpr bool LINEAR = LIN;
    static constexpr bool GATHER = LIN;
    int nM, nN, nwg, G, c; unsigned mg_nig;
    __device__ void init(int M, int N, int G_, int c_) { nM = M / BM; nN = N / BM; nwg = nM * nN; G = G_; c = c_; mg_nig = __builtin_amdgcn_readfirstlane(magic_of((unsigned)(WGM * nN))); }
    __device__ bool next(int i, Unit& u) const {
        const long L = (long)i * G + c; if (L >= nwg) return false;
        int wgid = (int)L; { const int q = nwg / NXCD, r = nwg % NXCD, xcd = wgid % NXCD, off = wgid / NXCD; wgid = (xcd < r ? xcd * (q + 1) : r * (q + 1) + (xcd - r) * q) + off; }
        const int nig = WGM * nN, gid = div_magic(wgid, mg_nig), rem = wgid - gid * nig, fm = gid * WGM, gsz = (nM - fm) < WGM ? (nM - fm) : WGM;
        int pn;
        if (gsz == WGM) pn = rem / WGM;
        else { const unsigned mg = gsz == 1 ? 65536u : gsz == 2 ? 32768u : gsz == 3 ? 21846u : gsz == 4 ? 16384u : gsz == 5 ? 13108u : gsz == 6 ? 10923u : 9363u; pn = (int)(((unsigned)rem * mg) >> 16); }
        u.pm = fm + (rem - pn * gsz); u.pn = pn; u.ex = 0; u.ploc = 0; return true;
    }
    __device__ __forceinline__ size_t bexp(const Unit&) const { return 0; }
    __device__ __forceinline__ int arow(const Unit& u, int r) const { return u.pm * BM + r; }
};
using DenseOrder = DenseOrderT<false>;
template <bool LIN> struct InProjL1OrderT {
    static constexpr bool GATHER = LIN, LINEAR = LIN;
    DenseOrder D; int G, c, nlat;
    __device__ void init(int G_, int c_) { D.init(ML, NPR, G_, 0); G = G_; c = c_; nlat = (ML / BM) * (NPR / BM); }
    __device__ bool next(int i, Unit& u) const {
        const int L = i * G + c;
        if (L < nlat) { DenseOrder T = D; T.c = c; return T.next(i, u); }
        const int q = L - nlat; if (q >= (MC / BM) * 5) return false;
        const int t = q % 5; u.pm = ML / BM + q / 5; u.pn = (t == 0) ? 5 : (t == 1) ? 6 : 5 + t + 1; u.ex = 0; u.ploc = 0; return true;
    }
    __device__ __forceinline__ size_t bexp(const Unit&) const { return 0; }
    __device__ __forceinline__ int arow(const Unit& u, int r) const { return u.pm * BM + r; }
};
using InProjL1Order = InProjL1OrderT<false>;
template <bool GATHER_, bool LINEAR_ = false> struct MoeOrder {
    static constexpr bool GATHER = GATHER_ || LINEAR_, LINEAR = LINEAR_;
    const int* rowtok;
    size_t bstride;
    int nN, G, c, npan; int pf[7]; unsigned mg_nN;
    __device__ void init(const unsigned* cnt_, const int* rowtok_, size_t bstride_, int N, int G_, int c_) { rowtok = rowtok_; bstride = bstride_; nN = N / BM; G = G_; c = c_;
        int acc = 0;
#pragma unroll
        for (int j = 0; j < NEXP; ++j) { const int cj = __builtin_amdgcn_readfirstlane((int)cnt_[j * 64]); acc += (cj + BM - 1) / BM; if (j < 7) pf[j] = acc; }
        npan = acc;
        mg_nN = __builtin_amdgcn_readfirstlane(magic_of((unsigned)nN)); }
    __device__ bool next(int i, Unit& u) const {
        const long L = (long)i * G + c; const int U = npan * nN; if (L >= U) return false;
        int wgid = (int)L; { const int q = U / NXCD, r = U % NXCD, xcd = wgid % NXCD, off = wgid / NXCD; wgid = (xcd < r ? xcd * (q + 1) : r * (q + 1) + (xcd - r) * q) + off; }
        u.pm = div_magic(wgid, mg_nN); u.pn = wgid - u.pm * nN;
        int e = 0, pb = 0;
#pragma unroll
        for (int j = 0; j < 7; ++j) if (u.pm >= pf[j]) { e = j + 1; pb = pf[j]; }
        u.ex = e; u.ploc = u.pm - pb; return true;
    }
    __device__ __forceinline__ size_t bexp(const Unit& u) const { return (size_t)u.ex * bstride; }
    __device__ __forceinline__ int arow(const Unit& u, int r) const { if (LINEAR_) return u.pm * BM + r; const int ts = rowtok[u.ex * 65536 + u.ploc * BM + r]; return ts < 0 ? 0 : (ts >> 1); }
};

template <class Epi, class Sched, int QM = 0>
__device__ __forceinline__ void gemm_phase(LAS unsigned char* lds, const int wv, const bf16* Aptr, const bf16* Btptr, const int K, const Sched& S, const Epi& E) {
    constexpr bool GATHER = Sched::GATHER, LINEAR = Sched::LINEAR; constexpr bool F8 = (QM == 1), I8 = (QM == 2);
    const int lane = lane_id_fresh(), wid = wv, tid = wid * 64 + lane, wr = wid >> 2, wc = wid & 3, fr = lane & 15, fq = lane >> 4;
    const int nt = K / BK;
    unsigned voffA[2], voffB[2];
#pragma unroll
    for (int i = 0; i < 2; ++i) { int R, C; stage_rc(tid * 16 + i * 8192, R, C); const int Rb = Epi::PERM ? ((R & ~31) + perm32(R & 31)) : R;
        voffA[i] = (unsigned)(R * K + C) * 2u; voffB[i] = (unsigned)(Rb * K + C) * 2u; }
    const size_t kstep = (size_t)(BK * 2);
    const size_t hstep = (size_t)HALF * K * 2;
    const size_t tstep = 2 * hstep;
    const unsigned ldsw = (unsigned)wid * 1024u;
    const int aoff = lds_byte(wr * 64 + fr, fq * 8), boff = lds_byte(wc * 32 + fr, fq * 8);
#define PG8_SA(b, h) (((b) * 2 + (h)) * HTB)
#define PG8_SB(b, h) ((4 + (b) * 2 + (h)) * HTB)
#define PG8_STAGE(bufoff, gbase, voff) do { _Pragma("unroll") for (int _i = 0; _i < 2; ++_i) \
        __builtin_amdgcn_global_load_lds((const unsigned*)((const char*)(gbase) + (voff)[_i]), (LAS unsigned*)(lds + (bufoff) + ldsw + _i * 8192), 16, 0, 0); } while (0)
#define PG8_LDA(dst, b, h) do { if constexpr (F8) { _Pragma("unroll") for (int m = 0; m < 4; ++m) dst##8[m] = __builtin_shufflevector(*(const LAS i32x4*)(lds + PG8_SA(b, h) + aoff + m * 2048), *(const LAS i32x4*)(lds + PG8_SA(b, h) + aoff + m * 2048 + 1024), 0, 1, 2, 3, 4, 5, 6, 7); } \
        else { _Pragma("unroll") for (int m = 0; m < 4; ++m) _Pragma("unroll") for (int k = 0; k < 2; ++k) dst[m][k] = *(const LAS bf16x8*)(lds + PG8_SA(b, h) + aoff + m * 2048 + k * 1024); } } while (0)
#define PG8_LDB(dst, b, h) do { if constexpr (F8) { _Pragma("unroll") for (int n = 0; n < 2; ++n) dst##8[n] = __builtin_shufflevector(*(const LAS i32x4*)(lds + PG8_SB(b, h) + boff + n * 2048), *(const LAS i32x4*)(lds + PG8_SB(b, h) + boff + n * 2048 + 1024), 0, 1, 2, 3, 4, 5, 6, 7); } \
        else { _Pragma("unroll") for (int n = 0; n < 2; ++n) _Pragma("unroll") for (int k = 0; k < 2; ++k) dst[n][k] = *(const LAS bf16x8*)(lds + PG8_SB(b, h) + boff + n * 2048 + k * 1024); } } while (0)
#define PG8_MMA(ai, bj, At, Bt) do { __builtin_amdgcn_s_setprio(1); \
        if constexpr (F8) { _Pragma("unroll") for (int m = 0; m < 4; ++m) _Pragma("unroll") for (int n = 0; n < 2; ++n) \
            acc[ai][bj][m][n] = __builtin_amdgcn_mfma_scale_f32_16x16x128_f8f6f4(Bt##8[n], At##8[m], acc[ai][bj][m][n], 0, 0, 0, 0x7F7F7F7F, 0, 0x7F7F7F7F); } \
        else if constexpr (I8) { _Pragma("unroll") for (int m = 0; m < 4; ++m) _Pragma("unroll") for (int n = 0; n < 2; ++n) _Pragma("unroll") for (int k = 0; k < 2; ++k) \
            acc[ai][bj][m][n] = __builtin_bit_cast(f32x4, __builtin_amdgcn_mfma_i32_16x16x64_i8(__builtin_bit_cast(i32x4, Bt[n][k]), __builtin_bit_cast(i32x4, At[m][k]), __builtin_bit_cast(i32x4, acc[ai][bj][m][n]), 0, 0, 0)); } \
        else { _Pragma("unroll") for (int m = 0; m < 4; ++m) _Pragma("unroll") for (int n = 0; n < 2; ++n) _Pragma("unroll") for (int k = 0; k < 2; ++k) \
            acc[ai][bj][m][n] = __builtin_amdgcn_mfma_f32_16x16x32_bf16(Bt[n][k], At[m][k], acc[ai][bj][m][n], 0, 0, 0); } \
        __builtin_amdgcn_s_setprio(0); } while (0)
#define PG8_WAIT_V(n) asm volatile("s_waitcnt vmcnt(" #n ")" ::: "memory")
#define PG8_WAIT_L(n) asm volatile("s_waitcnt lgkmcnt(" #n ")" ::: "memory")
#define PG8_BAR __builtin_amdgcn_s_barrier()
#define PG8_SCHED __builtin_amdgcn_sched_barrier(0)
    Unit cur, nxt; int ui = 0;
    if (!S.next(0, cur)) return;
    f32x4 acc[2][2][4][2];
#pragma unroll
    for (int a = 0; a < 2; ++a)
#pragma unroll
        for (int b = 0; b < 2; ++b)
#pragma unroll
            for (int m = 0; m < 4; ++m)
#pragma unroll
                for (int n = 0; n < 2; ++n) acc[a][b][m][n] = (f32x4){0.f, 0.f, 0.f, 0.f};
    bf16x8 At[4][2], B0[2][2], B1[2][2];
    i32x8 At8[4], B08[2], B18[2];
    unsigned gAc0[2], gAc1[2];
    LAS u32x4* gslot = (LAS u32x4*)(lds + STAGE_BYTES) + tid;
    if constexpr (GATHER) {
#pragma unroll
        for (int i = 0; i < 2; ++i) { int R, C; stage_rc(tid * 16 + i * 8192, R, C); gAc0[i] = (unsigned)(S.arow(cur, R) * K + C) * 2u; gAc1[i] = (unsigned)(S.arow(cur, HALF + R) * K + C) * 2u; }
    }
    const char* cA = GATHER ? (const char*)Aptr : (const char*)Aptr + (size_t)cur.pm * tstep;
    const char* cB = (const char*)Btptr + S.bexp(cur) + (size_t)cur.pn * tstep;
#define PG8_STAGE_A(bufoff, kbase, half, usenext) do { if constexpr (GATHER) { if (half) PG8_STAGE(bufoff, kbase, gAc1); else PG8_STAGE(bufoff, kbase, gAc0); } \
        else { PG8_STAGE(bufoff, (kbase) + ((half) ? hstep : 0), voffA); } } while (0)
    PG8_STAGE(PG8_SB(0, 0), cB, voffB); PG8_STAGE(PG8_SB(0, 1), cB + hstep, voffB); PG8_STAGE_A(PG8_SA(0, 0), cA, 0, false); PG8_STAGE_A(PG8_SA(0, 1), cA, 1, false);
    if (wr == 1) PG8_BAR;
    PG8_WAIT_V(2); PG8_BAR;
    PG8_STAGE(PG8_SB(1, 0), cB + kstep, voffB); PG8_STAGE_A(PG8_SA(1, 0), cA + kstep, 0, false); PG8_STAGE(PG8_SB(1, 1), cB + hstep + kstep, voffB);
    PG8_WAIT_V(6); PG8_BAR;
    for (;;) {
        const bool has_next = S.next(ui + 1, nxt);
        const char* nA = GATHER ? (const char*)Aptr : (has_next ? (const char*)Aptr + (size_t)nxt.pm * tstep : cA);
        const char* nB = has_next ? (const char*)Btptr + S.bexp(nxt) + (size_t)nxt.pn * tstep : cB;
        const unsigned lin_dlt = (LINEAR && has_next) ? (unsigned)((nxt.pm - cur.pm) * (int)tstep) : 0u;
        if constexpr (GATHER && !LINEAR) {
            u32x4 gn;
            if (has_next) { int R, C; stage_rc(tid * 16, R, C); gn.x = (unsigned)(S.arow(nxt, R) * K + C) * 2u; gn.z = (unsigned)(S.arow(nxt, HALF + R) * K + C) * 2u;
                stage_rc(tid * 16 + 8192, R, C); gn.y = (unsigned)(S.arow(nxt, R) * K + C) * 2u; gn.w = (unsigned)(S.arow(nxt, HALF + R) * K + C) * 2u; }
            else { gn.x = gAc0[0]; gn.y = gAc0[1]; gn.z = gAc1[0]; gn.w = gAc1[1]; }
            asm volatile("ds_write_b128 %0, %1" :: "v"((unsigned)(size_t)gslot), "v"(gn) : "memory");
        }
#pragma nounroll
        for (int t = 0; t < nt; t += 2) {
            const bool last = (t == nt - 2);
            const char* a1 = cA + (size_t)(t + 1) * kstep;
            const char* a2 = last ? nA : cA + (size_t)(t + 2) * kstep; const char* b2 = last ? nB : cB + (size_t)(t + 2) * kstep;
            const char* a3 = a2 + kstep; const char* b3 = b2 + kstep;
            PG8_LDB(B0, 0, 0); PG8_LDB(B1, 0, 1); PG8_SCHED; PG8_LDA(At, 0, 0); PG8_STAGE_A(PG8_SA(1, 1), a1, 1, false);
            if constexpr (GATHER) { if (last) {
                if constexpr (LINEAR) { gAc0[0] += lin_dlt; gAc0[1] += lin_dlt; gAc1[0] += lin_dlt; gAc1[1] += lin_dlt; }
                else { u32x4 gn; asm volatile("ds_read_b128 %0, %1\n\ts_waitcnt lgkmcnt(0)" : "=v"(gn) : "v"((unsigned)(size_t)gslot) : "memory"); gAc0[0] = gn.x; gAc0[1] = gn.y; gAc1[0] = gn.z; gAc1[1] = gn.w; } } }
            PG8_WAIT_V(8); PG8_WAIT_L(0); PG8_BAR; PG8_MMA(0, 0, At, B0); PG8_MMA(0, 1, At, B1); PG8_BAR; PG8_SCHED;
            PG8_LDA(At, 0, 1); PG8_STAGE(PG8_SB(0, 0), b2, voffB); PG8_STAGE(PG8_SB(0, 1), b2 + hstep, voffB); PG8_STAGE_A(PG8_SA(0, 0), a2, 0, last);
            PG8_WAIT_V(8); PG8_WAIT_L(0); PG8_BAR; PG8_MMA(1, 0, At, B0); PG8_MMA(1, 1, At, B1); PG8_BAR; PG8_SCHED;
            PG8_LDB(B0, 1, 0); PG8_LDB(B1, 1, 1); PG8_SCHED; PG8_LDA(At, 1, 0); PG8_STAGE_A(PG8_SA(0, 1), a2, 1, last);
            PG8_WAIT_V(8); PG8_WAIT_L(0); PG8_BAR; PG8_MMA(0, 0, At, B0); PG8_MMA(0, 1, At, B1); PG8_BAR; PG8_SCHED;
            PG8_LDA(At, 1, 1); PG8_STAGE(PG8_SB(1, 0), b3, voffB); PG8_STAGE(PG8_SB(1, 1), b3 + hstep, voffB); PG8_STAGE_A(PG8_SA(1, 0), a3, 0, last);
            PG8_WAIT_V(8); PG8_WAIT_L(0); PG8_BAR; PG8_MMA(1, 0, At, B0); PG8_MMA(1, 1, At, B1); PG8_BAR; PG8_SCHED;
        }
        if (wr == 0) PG8_BAR;
        if constexpr (I8) { const int ln_ = lane_id_fresh(); E(acc, cur, wr, wc, ln_ & 15, ln_ >> 4); }
        else E(acc, cur, wr, wc, fr, fq);
        if (!has_next) break;
#pragma unroll
        for (int a = 0; a < 2; ++a)
#pragma unroll
            for (int b = 0; b < 2; ++b)
#pragma unroll
                for (int m = 0; m < 4; ++m)
#pragma unroll
                    for (int n = 0; n < 2; ++n) acc[a][b][m][n] = (f32x4){0.f, 0.f, 0.f, 0.f};
        cur = nxt; cA = nA; cB = nB; ++ui;
        if (wr == 1) PG8_BAR;
    }
    PG8_WAIT_V(0);
    PG8_BAR;
#undef PG8_SA
#undef PG8_SB
#undef PG8_STAGE
#undef PG8_STAGE_A
#undef PG8_LDA
#undef PG8_LDB
#undef PG8_MMA
#undef PG8_WAIT_V
#undef PG8_WAIT_L
#undef PG8_BAR
#undef PG8_SCHED
}

struct EpiBf16Plain {
    static constexpr bool PERM = true;
    bf16* O; int ldc;
    __device__ __forceinline__ void operator()(const f32x4 (&acc)[2][2][4][2], const Unit& u, int wr, int wc, int fr, int fq) const {
        const int row0 = u.pm * BM + wr * 64 + fr, col0 = u.pn * BM + wc * 32 + 8 * fq;
#pragma unroll
        for (int ai = 0; ai < 2; ++ai)
#pragma unroll
            for (int m = 0; m < 4; ++m) { bf16* rowp = O + (size_t)(row0 + ai * HALF + m * 16) * ldc + col0;
#pragma unroll
                for (int bj = 0; bj < 2; ++bj) { const f32x4 v0 = acc[ai][bj][m][0], v1 = acc[ai][bj][m][1];
                    u32x4 w; w.x = pack2(v0[0], v0[1]); w.y = pack2(v0[2], v0[3]); w.z = pack2(v1[0], v1[1]); w.w = pack2(v1[2], v1[3]);
                    *(u32x4*)(rowp + bj * HALF) = w; } }
    }
};
template <bool SRC_F32> struct EpiResid {
    static constexpr bool PERM = true;
    bf16* XR; const float* xlat; const float* xctx; const float* gate;
    __device__ __forceinline__ void operator()(const f32x4 (&acc)[2][2][4][2], const Unit& u, int wr, int wc, int fr, int fq) const {
        const int m0 = u.pm * BM, row0 = m0 + wr * 64 + fr, col0 = u.pn * BM + wc * 32 + 8 * fq;
        const float* gp = gate + (size_t)(m0 < ML ? (m0 >> 11) : 32) * 6144 + col0;
        f32x4 g[2][2];
        bf16* xr = XR + (size_t)row0 * DM + col0;
#define EPR_GATE _Pragma("unroll") for (int bj = 0; bj < 2; ++bj) _Pragma("unroll") for (int n = 0; n < 2; ++n) g[bj][n] = *(const f32x4*)(gp + bj * HALF + 4 * n);
        if constexpr (!SRC_F32) {
            u32x4 sv[2][4][2];
#pragma unroll
            for (int ai = 0; ai < 2; ++ai)
#pragma unroll
                for (int m = 0; m < 4; ++m)
#pragma unroll
                    for (int bj = 0; bj < 2; ++bj) sv[ai][m][bj] = *(const u32x4*)(xr + (size_t)(ai * HALF + m * 16) * DM + bj * HALF);
            EPR_GATE
            __builtin_amdgcn_sched_barrier(0);
#pragma unroll
            for (int ai = 0; ai < 2; ++ai)
#pragma unroll
                for (int m = 0; m < 4; ++m)
#pragma unroll
                    for (int bj = 0; bj < 2; ++bj) { const u32x4 x = sv[ai][m][bj]; const f32x4 v0 = acc[ai][bj][m][0] * g[bj][0], v1 = acc[ai][bj][m][1] * g[bj][1];
                        u32x4 w; w.x = pack2(bflo(x.x) + v0[0], bfhi(x.x) + v0[1]); w.y = pack2(bflo(x.y) + v0[2], bfhi(x.y) + v0[3]); w.z = pack2(bflo(x.z) + v1[0], bfhi(x.z) + v1[1]); w.w = pack2(bflo(x.w) + v1[2], bfhi(x.w) + v1[3]);
                        *(u32x4*)(xr + (size_t)(ai * HALF + m * 16) * DM + bj * HALF) = w; }
        } else {
            const float* sp = (m0 < ML ? xlat + (size_t)row0 * DM : xctx + (size_t)(row0 - ML) * DM) + col0;
#pragma unroll
            for (int ai = 0; ai < 2; ++ai) {
                f32x4 sf[4][2][2];
#pragma unroll
                for (int m = 0; m < 4; ++m)
#pragma unroll
                    for (int bj = 0; bj < 2; ++bj)
#pragma unroll
                        for (int n = 0; n < 2; ++n) sf[m][bj][n] = *(const f32x4*)(sp + (size_t)(ai * HALF + m * 16) * DM + bj * HALF + 4 * n);
                if (ai == 0) { EPR_GATE }
                __builtin_amdgcn_sched_barrier(0);
#pragma unroll
                for (int m = 0; m < 4; ++m)
#pragma unroll
                    for (int bj = 0; bj < 2; ++bj) { const f32x4 v0 = sf[m][bj][0] + acc[ai][bj][m][0] * g[bj][0], v1 = sf[m][bj][1] + acc[ai][bj][m][1] * g[bj][1];
                        u32x4 w; w.x = pack2(v0[0], v0[1]); w.y = pack2(v0[2], v0[3]); w.z = pack2(v1[0], v1[1]); w.w = pack2(v1[2], v1[3]);
                        *(u32x4*)(xr + (size_t)(ai * HALF + m * 16) * DM + bj * HALF) = w; }
                __builtin_amdgcn_sched_barrier(0);
            }
        }
#undef EPR_GATE
    }
};
struct EpiInProj {
    static constexpr bool PERM = true;
    bf16* O; bf16* VT;
    __device__ __forceinline__ void operator()(const f32x4 (&acc)[2][2][4][2], const Unit& u, int wr, int wc, int fr, int fq) const {
        if (u.pn == 6) {
            const int m0 = u.pm * BM; int b, tb;
            if (m0 < ML) { b = m0 >> 11; tb = 256 + (m0 - (b << 11)); } else { b = (m0 - ML) >> 8; tb = 0; }
            bf16* vb = VT + (size_t)b * 256 * VT_LD + tb + wr * 64 + fr;
            const int c0 = wc * 32 + 8 * fq;
#pragma unroll
            for (int ai = 0; ai < 2; ++ai)
#pragma unroll
                for (int m = 0; m < 4; ++m)
#pragma unroll
                    for (int bj = 0; bj < 2; ++bj)
#pragma unroll
                        for (int n = 0; n < 2; ++n)
#pragma unroll
                            for (int e = 0; e < 4; ++e) vb[(size_t)(c0 + bj * HALF + 4 * n + e) * VT_LD + ai * HALF + m * 16] = f2bf(acc[ai][bj][m][n][e]);
            return;
        }
        const int row0 = u.pm * BM + wr * 64 + fr, col0 = u.pn * BM + wc * 32 + 8 * fq;
#pragma unroll
        for (int ai = 0; ai < 2; ++ai)
#pragma unroll
            for (int m = 0; m < 4; ++m) { bf16* rowp = O + (size_t)(row0 + ai * HALF + m * 16) * NPR + col0;
#pragma unroll
                for (int bj = 0; bj < 2; ++bj) { const f32x4 v0 = acc[ai][bj][m][0], v1 = acc[ai][bj][m][1];
                    u32x4 w; w.x = pack2(v0[0], v0[1]); w.y = pack2(v0[2], v0[3]); w.z = pack2(v1[0], v1[1]); w.w = pack2(v1[2], v1[3]);
                    *(u32x4*)(rowp + bj * HALF) = w; } }
    }
};
struct EpiInProjI8 {
    static constexpr bool PERM = true;
    bf16* O; bf16* VT; const float* rs; const float* cs;
    __device__ __forceinline__ void operator()(const f32x4 (&acc)[2][2][4][2], const Unit& u, int wr, int wc, int fr, int fq) const {
        const int row0 = u.pm * BM + wr * 64 + fr, col0 = u.pn * BM + wc * 32 + 8 * fq;
        f32x4 cv[2][2];
#pragma unroll
        for (int bj = 0; bj < 2; ++bj)
#pragma unroll
            for (int n = 0; n < 2; ++n) cv[bj][n] = *(const f32x4*)(cs + col0 + bj * HALF + 4 * n);
        if (u.pn == 6) {
            const int m0 = u.pm * BM; int b, tb;
            if (m0 < ML) { b = m0 >> 11; tb = 256 + (m0 - (b << 11)); } else { b = (m0 - ML) >> 8; tb = 0; }
            bf16* vb = VT + (size_t)b * 256 * VT_LD + tb + wr * 64 + fr;
            const int c0 = wc * 32 + 8 * fq;
#pragma unroll
            for (int ai = 0; ai < 2; ++ai)
#pragma unroll
                for (int m = 0; m < 4; ++m) { const float rsv = rs[row0 + ai * HALF + m * 16];
#pragma unroll
                    for (int bj = 0; bj < 2; ++bj)
#pragma unroll
                        for (int n = 0; n < 2; ++n)
#pragma unroll
                            for (int e = 0; e < 4; ++e) vb[(size_t)(c0 + bj * HALF + 4 * n + e) * VT_LD + ai * HALF + m * 16] = f2bf((float)__float_as_int(acc[ai][bj][m][n][e]) * (rsv * cv[bj][n][e])); }
            return;
        }
        float rsa[2][4];
#pragma unroll
        for (int ai = 0; ai < 2; ++ai)
#pragma unroll
            for (int m = 0; m < 4; ++m) rsa[ai][m] = rs[row0 + ai * HALF + m * 16];
        __builtin_amdgcn_sched_barrier(0);
#pragma unroll
        for (int ai = 0; ai < 2; ++ai)
#pragma unroll
            for (int m = 0; m < 4; ++m) { const int row = row0 + ai * HALF + m * 16; const float rsv = rsa[ai][m]; bf16* rowp = O + (size_t)row * NPR + col0;
#pragma unroll
                for (int bj = 0; bj < 2; ++bj) { float v[8];
#pragma unroll
                    for (int n = 0; n < 2; ++n)
#pragma unroll
                        for (int e = 0; e < 4; ++e) v[n * 4 + e] = (float)__float_as_int(acc[ai][bj][m][n][e]) * (rsv * cv[bj][n][e]);
                    u32x4 w; w.x = pack2(v[0], v[1]); w.y = pack2(v[2], v[3]); w.z = pack2(v[4], v[5]); w.w = pack2(v[6], v[7]);
                    *(u32x4*)(rowp + bj * HALF) = w; } }
    }
};
struct EpiSwiglu {
    static constexpr bool PERM = true;
    bf16* Hd; int ldc;
    __device__ __forceinline__ void operator()(const f32x4 (&acc)[2][2][4][2], const Unit& u, int wr, int wc, int fr, int fq) const {
        const int row0 = u.pm * BM + wr * 64 + fr, col0 = u.pn * HALF + wc * 32 + 8 * fq;
#pragma unroll
        for (int ai = 0; ai < 2; ++ai)
#pragma unroll
            for (int m = 0; m < 4; ++m) { bf16* rowp = Hd + (size_t)(row0 + ai * HALF + m * 16) * ldc + col0;
                float h[8];
#pragma unroll
                for (int n = 0; n < 2; ++n)
#pragma unroll
                    for (int j = 0; j < 4; ++j) { const float g = acc[ai][0][m][n][j], uu = acc[ai][1][m][n][j]; h[n * 4 + j] = g * __builtin_amdgcn_rcpf(1.0f + __expf(-g)) * uu; }
                u32x4 w; w.x = pack2(h[0], h[1]); w.y = pack2(h[2], h[3]); w.z = pack2(h[4], h[5]); w.w = pack2(h[6], h[7]);
                *(u32x4*)rowp = w; }
    }
};
struct EpiSwigluI8 {
    static constexpr bool PERM = true;
    bf16* Hd; int ldc; const float* rs; const float* cs; int F;
    __device__ __forceinline__ void operator()(const f32x4 (&acc)[2][2][4][2], const Unit& u, int wr, int wc, int fr, int fq) const {
        const int row0 = u.pm * BM + wr * 64 + fr, col0 = u.pn * HALF + wc * 32 + 8 * fq;
        const f32x4 cg0 = *(const f32x4*)(cs + col0), cg1 = *(const f32x4*)(cs + col0 + 4), cu0 = *(const f32x4*)(cs + F + col0), cu1 = *(const f32x4*)(cs + F + col0 + 4);
        float rsa[2][4];
#pragma unroll
        for (int ai = 0; ai < 2; ++ai)
#pragma unroll
            for (int m = 0; m < 4; ++m) rsa[ai][m] = rs[row0 + ai * HALF + m * 16];
        __builtin_amdgcn_sched_barrier(0);
#pragma unroll
        for (int ai = 0; ai < 2; ++ai)
#pragma unroll
            for (int m = 0; m < 4; ++m) { const int row = row0 + ai * HALF + m * 16; const float rsv = rsa[ai][m]; bf16* rowp = Hd + (size_t)row * ldc + col0;
                float h[8];
#pragma unroll
                for (int n = 0; n < 2; ++n)
#pragma unroll
                    for (int j = 0; j < 4; ++j) { const float g = (float)__float_as_int(acc[ai][0][m][n][j]) * (rsv * (n ? cg1[j] : cg0[j])), uu = (float)__float_as_int(acc[ai][1][m][n][j]) * (rsv * (n ? cu1[j] : cu0[j]));
                        h[n * 4 + j] = g * __builtin_amdgcn_rcpf(1.0f + __expf(-g)) * uu; }
                u32x4 w; w.x = pack2(h[0], h[1]); w.y = pack2(h[2], h[3]); w.z = pack2(h[4], h[5]); w.w = pack2(h[6], h[7]);
                *(u32x4*)rowp = w; }
    }
};
struct EpiSwigluF8 {
    static constexpr bool PERM = true;
    unsigned char* Hd;
    __device__ __forceinline__ void operator()(const f32x4 (&acc)[2][2][4][2], const Unit& u, int wr, int wc, int fr, int fq) const {
        const int row0 = u.pm * BM + wr * 64 + fr, col0 = u.pn * HALF + wc * 32 + 8 * fq;
#pragma unroll
        for (int ai = 0; ai < 2; ++ai)
#pragma unroll
            for (int m = 0; m < 4; ++m) { unsigned char* rowp = Hd + (size_t)(row0 + ai * HALF + m * 16) * DFEP + col0;
                float h[8];
#pragma unroll
                for (int n = 0; n < 2; ++n)
#pragma unroll
                    for (int j = 0; j < 4; ++j) { const float g = acc[ai][0][m][n][j] * (1.0f / W8S), uu = acc[ai][1][m][n][j] * (H8S / W8S); h[n * 4 + j] = g * __builtin_amdgcn_rcpf(1.0f + __expf(-g)) * uu; }
                u32x2 w; w.x = pack4_fp8(h[0], h[1], h[2], h[3]); w.y = pack4_fp8(h[4], h[5], h[6], h[7]);
                *(u32x2*)rowp = w;
                if (u.pn == DFE / HALF - 1) *(u32x2*)(rowp + HALF) = (u32x2){0u, 0u}; }
    }
};
struct EpiMoeOut {
    static constexpr bool PERM = true;
    bf16* Y; const int* rowtok; const float* gates;
    __device__ __forceinline__ void operator()(const f32x4 (&acc)[2][2][4][2], const Unit& u, int wr, int wc, int fr, int fq) const {
        const int prow0 = u.ploc * BM + wr * 64 + fr, col0 = u.pn * BM + wc * 32 + 8 * fq;
        int ts[2][4]; float gt[2][4];
#pragma unroll
        for (int ai = 0; ai < 2; ++ai)
#pragma unroll
            for (int m = 0; m < 4; ++m) ts[ai][m] = rowtok[u.ex * 65536 + prow0 + ai * HALF + m * 16];
#pragma unroll
        for (int ai = 0; ai < 2; ++ai)
#pragma unroll
            for (int m = 0; m < 4; ++m) gt[ai][m] = gates[max(ts[ai][m], 0)] * (1.0f / (W8S * H8S));
        __builtin_amdgcn_sched_barrier(0);
#pragma unroll
        for (int ai = 0; ai < 2; ++ai)
#pragma unroll
            for (int m = 0; m < 4; ++m) {
                if (ts[ai][m] >= 0) { const float g = gt[ai][m]; bf16* rowp = Y + (size_t)ts[ai][m] * DM + col0;
#pragma unroll
                    for (int bj = 0; bj < 2; ++bj) { const f32x4 v0 = acc[ai][bj][m][0] * g, v1 = acc[ai][bj][m][1] * g;
                        u32x4 w; w.x = pack2(v0[0], v0[1]); w.y = pack2(v0[2], v0[3]); w.z = pack2(v1[0], v1[1]); w.w = pack2(v1[2], v1[3]);
                        *(u32x4*)(rowp + bj * HALF) = w; } } }
    }
};
}

struct Args { const float* in[26]; float* out; unsigned char* ws; int ph_lo, ph_hi; };
struct Frame {
    LAS unsigned char* lds; int G, bid, wv;
    float* out; unsigned char* ws;
};
__device__ __forceinline__ const float* inptr(const Frame& F, int i) {
    const LAS unsigned* t = (const LAS unsigned*)(F.lds + LDSCTL_OFF + 16) + 2 * i;
    const unsigned lo = __builtin_amdgcn_readfirstlane(t[0]), hi = __builtin_amdgcn_readfirstlane(t[1]);
    const GAS float* gp = (const GAS float*)(((unsigned long long)hi << 32) | lo);
    return (const float*)gp;
}
enum { I_X = 0, I_C, I_CTX, I_CCTX, I_WADA, I_BADA, I_GMIX, I_GFFN, I_WIN, I_WOUT, I_POOLW, I_POOLS, I_CONVW, I_RPB, I_SCW, I_SCB, I_SDTB, I_SALOG, I_SD, I_SNG, I_FGU, I_FDOWN, I_ROUTER, I_MGU, I_MDOWN, I_GFINAL };

#define PHASE_IDS const int lane = lane_id_fresh(), wave = F.wv, tid = wave * 64 + lane; (void)lane; (void)wave; (void)tid;
struct TJob { const float* src; bf16* dst; const float* cs; int ldn, k0, n0, ldk, Fm, f8; };
__device__ __forceinline__ void tconv_load(const TJob& J, int tid, f32x4& v0, f32x4& v1) {
    const int r = tid >> 4, c4 = tid & 15;
    const GAS float* p = (const GAS float*)J.src + (size_t)(J.k0 + r) * J.ldn + J.n0 + 4 * c4;
    v0 = *(const GAS f32x4*)p; v1 = *(const GAS f32x4*)(p + (size_t)32 * J.ldn);
}
__device__ __forceinline__ void tconv_lds(const f32x4& v0, const f32x4& v1, LAS float* tile, int tid) {
    const int r = tid >> 4, c4 = tid & 15;
    { LAS float* t = tile + r * 65 + 4 * c4; t[0] = v0[0]; t[1] = v0[1]; t[2] = v0[2]; t[3] = v0[3]; }
    { LAS float* t = tile + (r + 32) * 65 + 4 * c4; t[0] = v1[0]; t[1] = v1[1]; t[2] = v1[2]; t[3] = v1[3]; }
}
__device__ __forceinline__ void tconv_emit(const TJob& J, const LAS float* tile, int tid) {
    const int n = tid >> 3, ks = tid & 7;
    float f[8];
#pragma unroll
    for (int i = 0; i < 8; ++i) f[i] = tile[(ks * 8 + i) * 65 + n];
    const int nn = J.n0 + n; int drow = nn;
    if (J.Fm) { const int isu = nn >= J.Fm; const int j = isu ? nn - J.Fm : nn; drow = (j >> 7) * 256 + (isu ? 128 : 0) + (j & 127); }
    if (J.f8 == 2) { const float inv = 1.0f / J.cs[nn]; u32x2 w8; w8.x = pack4_i8(f[0] * inv, f[1] * inv, f[2] * inv, f[3] * inv); w8.y = pack4_i8(f[4] * inv, f[5] * inv, f[6] * inv, f[7] * inv);
        *(u32x2*)((unsigned char*)J.dst + (size_t)drow * J.ldk + J.k0 + ks * 8) = w8; }
    else if (J.f8) { u32x2 w8; w8.x = pack4_fp8(f[0] * W8S, f[1] * W8S, f[2] * W8S, f[3] * W8S); w8.y = pack4_fp8(f[4] * W8S, f[5] * W8S, f[6] * W8S, f[7] * W8S);
        *(u32x2*)((unsigned char*)J.dst + (size_t)drow * J.ldk + J.k0 + ks * 8) = w8; }
    else { u32x4 w; w.x = pack2(f[0], f[1]); w.y = pack2(f[2], f[3]); w.z = pack2(f[4], f[5]); w.w = pack2(f[6], f[7]);
        *(u32x4*)(J.dst + (size_t)drow * J.ldk + J.k0 + ks * 8) = w; }
}
__device__ __forceinline__ TJob tdecode(const Frame& F, int T) {
    unsigned char* wb = F.ws + WS_WB;
    TJob J; J.Fm = 0; J.f8 = 0; J.cs = nullptr;
    if (T < 1408) { const int l = T / 704, t = T % 704; J.src = inptr(F, I_WIN) + (size_t)l * DM * DIN; J.ldn = DIN; J.k0 = (t / 44) * 64; J.n0 = (t % 44) * 64; J.dst = (bf16*)(wb + WB_IN + l * WB_IN_SZ); J.ldk = DM;
        J.f8 = 2; J.cs = (const float*)(F.ws + WS_CSIN) + l * NPR; }
    else if (T < 1920) { const int q = T - 1408, l = q / 256, t = q % 256; J.src = inptr(F, I_WOUT) + (size_t)l * DM * DM; J.ldn = DM; J.k0 = (t / 16) * 64; J.n0 = (t % 16) * 64; J.dst = (bf16*)(wb + WB_OUT + l * WB_OUT_SZ); J.ldk = DM; }
    else if (T < 3328) { const int t = T - 1920; J.src = inptr(F, I_FGU); J.ldn = 2 * DFF; J.k0 = (t / 88) * 64; J.n0 = (t % 88) * 64; J.dst = (bf16*)(wb + WB_GU); J.ldk = DM; J.Fm = DFF; J.f8 = 2; J.cs = (const float*)(F.ws + WS_CS); }
    else if (T < 4032) { const int t = T - 3328; J.src = inptr(F, I_FDOWN); J.ldn = DM; J.k0 = (t / 16) * 64; J.n0 = (t % 16) * 64; J.dst = (bf16*)(wb + WB_DOWN); J.ldk = DFF; }
    else if (T < 9664) { const int q = T - 4032, e = q / 704, t = q % 704; J.src = inptr(F, I_MGU) + (size_t)e * DM * 2 * DFE; J.ldn = 2 * DFE; J.k0 = (t / 44) * 64; J.n0 = (t % 44) * 64; J.dst = (bf16*)(wb + WB_MGU + e * WB_MGU_SZ); J.ldk = DM; J.Fm = DFE; J.f8 = 1; }
    else { const int q = T - 9664, e = q / 352, t = q % 352; J.src = inptr(F, I_MDOWN) + (size_t)e * DFE * DM; J.ldn = DM; J.k0 = (t / 16) * 64; J.n0 = (t % 16) * 64; J.dst = (bf16*)(wb + WB_MDOWN + e * WB_MDOWN_SZ); J.ldk = DFEP; J.f8 = 1; }
    return J;
}
__device__ __forceinline__ void conv_tiles(const Frame& F, const int lo0, const int n0, const int lo1, const int n1, const int w, const int nw) {
    PHASE_IDS
    constexpr int NT = 4;
    LAS float* ldsf = (LAS float*)F.lds;
    const int nT = n0 + n1;
#define TV(v) ((v) < n0 ? lo0 + (v) : lo1 + ((v) - n0))
    int g = w;
    if (g * NT >= nT) return;
    f32x4 cv[NT][2], nv[NT][2];
#pragma unroll
    for (int j = 0; j < NT; ++j) { cv[j][0] = cv[j][1] = (f32x4){0.f, 0.f, 0.f, 0.f}; if (g * NT + j < nT) { const TJob J = tdecode(F, TV(g * NT + j)); tconv_load(J, tid, cv[j][0], cv[j][1]); } }
    for (; g * NT < nT; g += nw) {
        const int gn = g + nw;
#pragma unroll
        for (int j = 0; j < NT; ++j) { nv[j][0] = cv[j][0]; nv[j][1] = cv[j][1]; if (gn * NT + j < nT) { const TJob J = tdecode(F, TV(gn * NT + j)); tconv_load(J, tid, nv[j][0], nv[j][1]); } }
#pragma unroll
        for (int j = 0; j < NT; ++j) if (g * NT + j < nT) tconv_lds(cv[j][0], cv[j][1], ldsf + j * (64 * 65), tid);
        __syncthreads();
#pragma unroll
        for (int j = 0; j < NT; ++j) if (g * NT + j < nT) { const TJob J = tdecode(F, TV(g * NT + j)); tconv_emit(J, ldsf + j * (64 * 65), tid); }
        __syncthreads();
#pragma unroll
        for (int j = 0; j < NT; ++j) { cv[j][0] = nv[j][0]; cv[j][1] = nv[j][1]; }
    }
#undef TV
}
__device__ __forceinline__ bool tail_worker(const Frame& F, int nunits, int& w, int& nw) { const int r = nunits % F.G; w = F.bid - r; nw = F.G - r; return F.bid >= r; }
__device__ __forceinline__ void p0_prologue(const Frame& F) {
    PHASE_IDS
    unsigned char* wb = F.ws + WS_WB;
    LAS float* ldsf = (LAS float*)F.lds;
    if (F.bid < 192) {
        constexpr int ADA_LD = 1028;
        const int l = F.bid / 96, cg = F.bid % 96;
        { const GAS float* cl = (const GAS float*)inptr(F, I_C); const GAS float* cx = (const GAS float*)inptr(F, I_CCTX);
          f32x4 cv[17];
#pragma unroll
          for (int it = 0; it < 17; ++it) { const int i4 = tid + 512 * it, b = i4 >> 8, k4 = i4 & 255; cv[it] = (f32x4){0.f, 0.f, 0.f, 0.f};
              if (i4 < 33 * 256) cv[it] = (b < 32) ? *(const GAS f32x4*)(cl + b * 1024 + 4 * k4) : *(const GAS f32x4*)(cx + 4 * k4); }
#pragma unroll
          for (int it = 0; it < 17; ++it) { const int i4 = tid + 512 * it, b = i4 >> 8, k4 = i4 & 255;
              if (i4 < 33 * 256) { f32x4 sv; sv[0] = silu_f(cv[it][0]); sv[1] = silu_f(cv[it][1]); sv[2] = silu_f(cv[it][2]); sv[3] = silu_f(cv[it][3]); *(LAS f32x4*)(ldsf + b * ADA_LD + 4 * k4) = sv; } } }
        __syncthreads();
        const int lq = lane & 15, g = lane >> 4;
        f32x4 acc[3][4];
#pragma unroll
        for (int mt = 0; mt < 3; ++mt)
#pragma unroll
            for (int nt = 0; nt < 4; ++nt) acc[mt][nt] = (f32x4){0.f, 0.f, 0.f, 0.f};
        const GAS float* wbase = (const GAS float*)inptr(F, I_WADA) + (size_t)l * 1024 * 6144 + cg * 64 + lq + (size_t)(wave * 128 + 8 * g) * 6144;
        float wc[4][8], wn[4][8];
#define ADA_WLOAD(dst, ks) do { _Pragma("unroll") for (int nt = 0; nt < 4; ++nt) _Pragma("unroll") for (int j = 0; j < 8; ++j) dst[nt][j] = wbase[(size_t)((ks) * 32 + j) * 6144 + 16 * nt]; } while (0)
#define ADA_SPLIT(v, hi, lo) do { u32x4 h_, l_; _Pragma("unroll") for (int i = 0; i < 4; ++i) { const unsigned ph_ = pack2(v[2 * i], v[2 * i + 1]); h_[i] = ph_; l_[i] = pack2(v[2 * i] - bflo(ph_), v[2 * i + 1] - bfhi(ph_)); } \
            hi = __builtin_bit_cast(bf16x8, h_); lo = __builtin_bit_cast(bf16x8, l_); } while (0)
        ADA_WLOAD(wc, 0);
#pragma unroll
        for (int ks = 0; ks < 4; ++ks) {
            if (ks + 1 < 4) ADA_WLOAD(wn, ks + 1);
            bf16x8 ah[3], al[3];
#pragma unroll
            for (int mt = 0; mt < 3; ++mt) { const int row = min(16 * mt + lq, 32); const LAS float* ap = ldsf + row * ADA_LD + wave * 128 + ks * 32 + 8 * g;
                const f32x4 a0 = *(const LAS f32x4*)ap, a1 = *(const LAS f32x4*)(ap + 4); const float av[8] = {a0[0], a0[1], a0[2], a0[3], a1[0], a1[1], a1[2], a1[3]};
                ADA_SPLIT(av, ah[mt], al[mt]); }
#pragma unroll
            for (int nt = 0; nt < 4; ++nt) { bf16x8 wh, wl; ADA_SPLIT(wc[nt], wh, wl);
#pragma unroll
                for (int mt = 0; mt < 3; ++mt) { acc[mt][nt] = __builtin_amdgcn_mfma_f32_16x16x32_bf16(ah[mt], wh, acc[mt][nt], 0, 0, 0); acc[mt][nt] = __builtin_amdgcn_mfma_f32_16x16x32_bf16(ah[mt], wl, acc[mt][nt], 0, 0, 0);
                    acc[mt][nt] = __builtin_amdgcn_mfma_f32_16x16x32_bf16(al[mt], wh, acc[mt][nt], 0, 0, 0); } }
#pragma unroll
            for (int nt = 0; nt < 4; ++nt)
#pragma unroll
                for (int j = 0; j < 8; ++j) wc[nt][j] = wn[nt][j];
        }
#undef ADA_WLOAD
#undef ADA_SPLIT
        __syncthreads();
#pragma unroll
        for (int mt = 0; mt < 3; ++mt)
#pragma unroll
            for (int nt = 0; nt < 4; ++nt) *(LAS f32x4*)(ldsf + ((wave * 12 + mt * 4 + nt) * 64 + lane) * 4) = acc[mt][nt];
        __syncthreads();
        float* mod = (float*)(F.ws + WS_MOD) + (size_t)l * 33 * 6144;
        for (int idx = tid; idx < 33 * 64; idx += 512) { const int b = idx >> 6, n = idx & 63; const int mt = b >> 4, gg = (b & 15) >> 2, e = b & 3, nt = n >> 4, ll = gg * 16 + (n & 15); float sm = 0.f;
#pragma unroll
            for (int w = 0; w < 8; ++w) sm += ldsf[((w * 12 + mt * 4 + nt) * 64 + ll) * 4 + e];
            mod[(size_t)b * 6144 + cg * 64 + n] = sm + inptr(F, I_BADA)[l * 6144 + cg * 64 + n]; }
        __syncthreads();
    }
    for (int cgp = F.G - 1 - F.bid; cgp < 176; cgp += F.G) {
        const bool isin = cgp >= 88; const int lyr = cgp >= 132; const int n0 = (isin ? (cgp - 88) % 44 : cgp) * 64; const int ldw = isin ? DIN : 2 * DFF;
        const int c4 = tid & 15, ks = tid >> 4;
        const GAS float* wsrc = (const GAS float*)(isin ? inptr(F, I_WIN) + (size_t)lyr * DM * DIN : inptr(F, I_FGU)) + n0 + 4 * c4 + (size_t)(ks * 32) * ldw;
        f32x4 am = (f32x4){0.f, 0.f, 0.f, 0.f};
#pragma unroll
        for (int k = 0; k < 32; ++k) { const f32x4 v = *(const GAS f32x4*)(wsrc + (size_t)k * ldw); am[0] = fmaxf(am[0], fabsf(v[0])); am[1] = fmaxf(am[1], fabsf(v[1])); am[2] = fmaxf(am[2], fabsf(v[2])); am[3] = fmaxf(am[3], fabsf(v[3])); }
        __syncthreads();
        *(LAS f32x4*)(ldsf + ks * 64 + 4 * c4) = am;
        __syncthreads();
        if (tid < 64) { float m8 = 0.f;
#pragma unroll
            for (int q = 0; q < 32; ++q) m8 = fmaxf(m8, ldsf[q * 64 + tid]);
            ((float*)(F.ws + (isin ? WS_CSIN : WS_CS)))[lyr * NPR + n0 + tid] = fmaxf(m8, 1.0e-20f) * (1.0f / 127.0f); }
        __syncthreads(); }
    for (int idx = F.bid * 512 + tid; idx < NEXP * 65536 / 4; idx += F.G * 512) *(u32x4*)(F.ws + WS_LISTE + (size_t)idx * 16) = (u32x4){0xFFFFFFFFu, 0xFFFFFFFFu, 0xFFFFFFFFu, 0xFFFFFFFFu};
    for (int idx = F.bid * 512 + tid; idx < NEXP * DM * 8; idx += F.G * 512) { const int rr = idx >> 3, q = idx & 7; *(u32x4*)(wb + WB_MDOWN + (size_t)rr * DFEP + DFE + q * 16) = (u32x4){0u, 0u, 0u, 0u}; }
}

template <int L, int MODE, bool SRC_XR, bool HAS_D>
__device__ __forceinline__ void norm_phase(const Frame& F, int nrows, const bf16* Dbuf, const float* gate) {
    PHASE_IDS
    const float* mod = (const float*)(F.ws + WS_MOD) + (size_t)L * 33 * 6144;
    constexpr bool M0 = (MODE == 0 || MODE == 6);
    const int sh_off = M0 ? 0 : 3 * 1024, sc_off = sh_off + 1024;
    const float* gsrc = (M0 ? inptr(F, I_GMIX) : inptr(F, I_GFFN)) + L * DM;
    bf16* HB = (bf16*)(F.ws + WS_HB);
    float* DT = (float*)(F.ws + WS_DT);
    bf16* XR = (bf16*)(F.ws + WS_XR);
    f32x4 wx[16][2];
    if (M0 || MODE == 2) {
#pragma unroll
        for (int j = 0; j < 4; ++j)
#pragma unroll
            for (int i = 0; i < 4; ++i) { const int k = j * 256 + lane * 4 + i;
                const float* p = M0 ? inptr(F, I_WIN) + (size_t)L * DM * DIN + (size_t)k * DIN + NPR : inptr(F, I_ROUTER) + (size_t)k * NEXP;
                wx[j * 4 + i][0] = *(const f32x4*)p; wx[j * 4 + i][1] = *(const f32x4*)(p + 4); }
    }
    const int per = (nrows + F.G * 8 - 1) / (F.G * 8), mbeg = (F.bid * 8 + wave) * per, mend = min(mbeg + per, nrows);
    f32x4 ga[4], sha[4], gtv[4]; int curmod = -1; int my_i1 = -1, my_i2 = -1;
    f32x4 v[4], vn[4]; u32x2 xb[4], xbn[4], dl[4], dln[4];
    const GAS float* xlat_p = (const GAS float*)inptr(F, I_X); const GAS float* xctx_p = (const GAS float*)inptr(F, I_CTX);
#define NP_LOAD(m, V, XB, DL) do { \
        if (SRC_XR) { const GAS bf16* s_ = (const GAS bf16*)XR + (size_t)(m) * DM + lane * 4; _Pragma("unroll") for (int j = 0; j < 4; ++j) XB[j] = *(const GAS u32x2*)(s_ + j * 256); } \
        else { const GAS float* s_ = (((m) < ML) ? xlat_p + (size_t)(m) * DM : xctx_p + (size_t)((m) - ML) * DM) + lane * 4; _Pragma("unroll") for (int j = 0; j < 4; ++j) V[j] = *(const GAS f32x4*)(s_ + j * 256); } \
        if (HAS_D) { const GAS bf16* d_ = (const GAS bf16*)Dbuf + (size_t)(m) * DM + lane * 4; _Pragma("unroll") for (int j = 0; j < 4; ++j) DL[j] = *(const GAS u32x2*)(d_ + j * 256); } } while (0)
    if (mbeg < mend) NP_LOAD(mbeg, v, xb, dl);
    for (int m = mbeg; m < mend; ++m) {
        if (m + 1 < mend) NP_LOAD(m + 1, vn, xbn, dln);
        const int mi = modidx_of(m);
        if (mi != curmod) { curmod = mi; const float* mrow = mod + (size_t)mi * 6144;
#pragma unroll
            for (int j = 0; j < 4; ++j) { const int e = j * 256 + lane * 4; const f32x4 g = *(const f32x4*)(gsrc + e), sc = *(const f32x4*)(mrow + sc_off + e); ga[j] = g * (sc + 1.0f); sha[j] = *(const f32x4*)(mrow + sh_off + e);
                if (HAS_D) gtv[j] = *(const f32x4*)(gate + (size_t)mi * 6144 + e); } }
        float ss = 0.f;
#pragma unroll
        for (int j = 0; j < 4; ++j) {
            if (SRC_XR) { v[j][0] = bflo(xb[j].x); v[j][1] = bfhi(xb[j].x); v[j][2] = bflo(xb[j].y); v[j][3] = bfhi(xb[j].y); }
            if (HAS_D) { f32x4 dv; dv[0] = bflo(dl[j].x); dv[1] = bfhi(dl[j].x); dv[2] = bflo(dl[j].y); dv[3] = bfhi(dl[j].y); v[j] = v[j] + gtv[j] * dv;
                u32x2 w; w.x = pack2(v[j][0], v[j][1]); w.y = pack2(v[j][2], v[j][3]); *(u32x2*)(XR + (size_t)m * DM + j * 256 + lane * 4) = w; }
            ss += v[j][0] * v[j][0] + v[j][1] * v[j][1] + v[j][2] * v[j][2] + v[j][3] * v[j][3];
        }
        ss = wave_sum(ss);
        const float rstd = rsqrtf(ss * (1.0f / DM) + EPS);
        float d8[8];
#pragma unroll
        for (int q = 0; q < 8; ++q) d8[q] = 0.f;
        if (MODE == 5) {
            f32x4 hh[4]; float am = 0.f;
#pragma unroll
            for (int j = 0; j < 4; ++j) { hh[j] = v[j] * rstd * ga[j] + sha[j]; am = fmaxf(am, fmaxf(fmaxf(fabsf(hh[j][0]), fabsf(hh[j][1])), fmaxf(fabsf(hh[j][2]), fabsf(hh[j][3])))); }
            am = fmaxf(wave_max_dpp(am), 1.0e-20f);
            const float inv = 127.0f / am;
#pragma unroll
            for (int j = 0; j < 4; ++j) *(unsigned*)((unsigned char*)HB + (size_t)m * DM + j * 256 + lane * 4) = pack4_i8(hh[j][0] * inv, hh[j][1] * inv, hh[j][2] * inv, hh[j][3] * inv);
            if (lane == 0) ((float*)(F.ws + WS_RS))[m] = am * (1.0f / 127.0f);
        }
        f32x4 hq[4]; float amq = 0.f; (void)hq;
        if (MODE != 5) {
#pragma unroll
        for (int j = 0; j < 4; ++j) {
            const int e = j * 256 + lane * 4;
            f32x4 h = v[j] * rstd * ga[j] + sha[j];
            if (MODE == 2) *(unsigned*)((unsigned char*)HB + (size_t)m * DM + e) = pack4_fp8(h[0], h[1], h[2], h[3]);
            else if (MODE == 6) { hq[j] = h; amq = fmaxf(amq, fmaxf(fmaxf(fabsf(h[0]), fabsf(h[1])), fmaxf(fabsf(h[2]), fabsf(h[3])))); }
            else { u32x2 w; w.x = pack2(h[0], h[1]); w.y = pack2(h[2], h[3]); *(u32x2*)(HB + (size_t)m * DM + e) = w; }
            if (M0 || MODE == 2) {
#pragma unroll
                for (int i = 0; i < 4; ++i) {
#pragma unroll
                    for (int q = 0; q < 4; ++q) { d8[q] += h[i] * wx[j * 4 + i][0][q]; d8[4 + q] += h[i] * wx[j * 4 + i][1][q]; } }
            }
        }
        }
        if (MODE == 6) { amq = fmaxf(wave_max_dpp(amq), 1.0e-20f); const float inv = 127.0f / amq;
#pragma unroll
            for (int j = 0; j < 4; ++j) *(unsigned*)((unsigned char*)HB + (size_t)m * DM + j * 256 + lane * 4) = pack4_i8(hq[j][0] * inv, hq[j][1] * inv, hq[j][2] * inv, hq[j][3] * inv);
            if (lane == 0) ((float*)(F.ws + WS_RS))[m] = amq * (1.0f / 127.0f); }
        float dred = 0.f;
        if (M0 || MODE == 2) {
            const bool h5 = (lane & 32) != 0, h4 = (lane & 16) != 0, h3 = (lane & 8) != 0;
            float a4[4];
#pragma unroll
            for (int q = 0; q < 4; ++q) { const float keep = h5 ? d8[4 + q] : d8[q], send = h5 ? d8[q] : d8[4 + q]; a4[q] = keep + __shfl_xor(send, 32); }
            float a2[2];
#pragma unroll
            for (int q = 0; q < 2; ++q) { const float keep = h4 ? a4[2 + q] : a4[q], send = h4 ? a4[q] : a4[2 + q]; a2[q] = keep + __shfl_xor(send, 16); }
            { const float keep = h3 ? a2[1] : a2[0], send = h3 ? a2[0] : a2[1]; dred = keep + __shfl_xor(send, 8); }
            dred = row8_sum(dred);
        }
        if (M0) {
            if ((lane & 7) == 0) DT[(size_t)m * 8 + (lane >> 3)] = dred;
        }
        if (MODE == 2) {
#pragma unroll
            for (int q = 0; q < 8; ++q) d8[q] = __shfl(dred, 8 * q);
            int i1 = 0; float v1 = d8[0];
#pragma unroll
            for (int q = 1; q < 8; ++q) if (d8[q] > v1) { v1 = d8[q]; i1 = q; }
            int i2 = -1; float v2 = -3.0e38f;
#pragma unroll
            for (int q = 0; q < 8; ++q) if (q != i1 && d8[q] > v2) { v2 = d8[q]; i2 = q; }
            if (lane == 0) {
                const float g1 = 1.0f / (1.0f + __expf(v2 - v1));
                int* te = (int*)(F.ws + WS_ROUTE); float* tg = (float*)(te + 4 * ML);
                te[2 * m] = i1; te[2 * m + 1] = i2; tg[2 * m] = g1; tg[2 * m + 1] = 1.0f - g1;
            }
            if (lane == m - mbeg) { my_i1 = i1; my_i2 = i2; }
        }
#pragma unroll
        for (int j = 0; j < 4; ++j) { v[j] = vn[j]; xb[j] = xbn[j]; dl[j] = dln[j]; }
    }
#undef NP_LOAD
    if (MODE == 2) {
        LAS unsigned* lc = (LAS unsigned*)F.lds;
        __syncthreads();
        if (tid < 16) lc[tid] = 0u;
        __syncthreads();
        unsigned wbase1 = 0u, rank1 = 0u, rank2 = 0u; unsigned n1mine = 0u;
        const unsigned long long lt = (lane == 0) ? 0ull : (~0ull >> (64 - lane));
#pragma unroll
        for (int e = 0; e < 8; ++e) {
            const unsigned long long m1 = __ballot(my_i1 == e), m2 = __ballot(my_i2 == e);
            const unsigned c1 = (unsigned)__popcll(m1), c2 = (unsigned)__popcll(m2);
            unsigned wb = 0u;
            if (lane == 0 && (c1 + c2) != 0u) wb = __hip_atomic_fetch_add(lc + e, c1 + c2, __ATOMIC_RELAXED, __HIP_MEMORY_SCOPE_WORKGROUP);
            wb = (unsigned)__shfl((int)wb, 0);
            if (my_i1 == e) { wbase1 = wb; rank1 = (unsigned)__popcll(m1 & lt); }
            if (my_i2 == e) { n1mine = wb + c1; rank2 = (unsigned)__popcll(m2 & lt); }
        }
        __syncthreads();
        if (tid < 8) { const unsigned c = lc[tid]; lc[8 + tid] = c ? atomicAdd((unsigned*)(F.ws + WS_CTL) + CW_CNT + tid * 64, c) : 0u; }
        __syncthreads();
        if (my_i1 >= 0) { const int m = mbeg + lane; int* liste = (int*)(F.ws + WS_LISTE);
            liste[my_i1 * 65536 + (int)(lc[8 + my_i1] + wbase1 + rank1)] = 2 * m; liste[my_i2 * 65536 + (int)(lc[8 + my_i2] + n1mine + rank2)] = 2 * m + 1; }
        __syncthreads();
    }
}

constexpr int SS_LD = 272;
constexpr int SS_BM = 0, SS_CM = 128 * SS_LD, SS_BT = 2 * 128 * SS_LD, SS_XT = 3 * 128 * SS_LD, SS_HS = SS_XT + 64 * SS_LD, SS_AC = SS_HS + 64 * SS_LD, SS_DT = SS_AC + 512, SS_SC = SS_DT + 512;
static_assert(SS_SC + 512 <= LDSCTL_OFF, "ssd LDS map");
template <int V> struct IntC { static constexpr int value = V; };
template <int L>
__device__ __forceinline__ void ssd_scan_mfma(const Frame& F, bf16* Yd) {
    PHASE_IDS
    const bf16* PR = (const bf16*)(F.ws + WS_PRB);
    const float* DT = (const float*)(F.ws + WS_DT);
    LAS unsigned char* lb = F.lds;
    LAS float* acum = (LAS float*)(lb + SS_AC); LAS float* dtv = (LAS float*)(lb + SS_DT); LAS float* scl = (LAS float*)(lb + SS_SC);
    const float* cw = inptr(F, I_SCW) + (size_t)L * 3 * 768; const float* cb = inptr(F, I_SCB) + (size_t)L * 768;
    const int lq = lane & 15, g = lane >> 4;
    for (int item = F.bid; item < NB * 2 * 4; item += F.G) {
        const int b = item >> 3, d = (item >> 2) & 1, hd = item & 3, grp = hd >> 1;
        const float a = -__expf(inptr(F, I_SALOG)[(L * 2 + d) * 4 + hd]);
        const float dtb = inptr(F, I_SDTB)[(L * 2 + d) * 4 + hd];
        const float dsk = (d == 0) ? inptr(F, I_SD)[L * 4 + hd] : 0.f;
        const int xix = hd * 64 + lane, xib = 256 + grp * 128 + 2 * lane, xic = 512 + grp * 128 + 2 * lane;
        const float wx0 = cw[xix], wx1 = cw[768 + xix], wx2 = cw[1536 + xix], bx = cb[xix];
        const float wb00 = cw[xib], wb01 = cw[768 + xib], wb02 = cw[1536 + xib], bb0 = cb[xib], wb10 = cw[xib + 1], wb11 = cw[768 + xib + 1], wb12 = cw[1536 + xib + 1], bb1 = cb[xib + 1];
        const float wc00 = cw[xic], wc01 = cw[768 + xic], wc02 = cw[1536 + xic], bc0 = cb[xic], wc10 = cw[xic + 1], wc11 = cw[768 + xic + 1], wc12 = cw[1536 + xic + 1], bc1 = cb[xic + 1];
        f32x4 Hacc[4];
#pragma unroll
        for (int pt = 0; pt < 4; ++pt) Hacc[pt] = (f32x4){0.f, 0.f, 0.f, 0.f};
        __syncthreads();
        for (int i = tid; i < 64 * SS_LD / 4; i += 512) ((LAS unsigned*)(lb + SS_HS))[i] = 0u;
#define SSD_GEOM(chn) const bool isctx = (chn) < 2; const int Ls = isctx ? 256 : 2048, rowbase = isctx ? ML + b * 256 : b * 2048, sb = isctx ? (chn) * 128 : ((chn) - 2) * 128; const int p0 = d ? Ls - 128 - sb : sb;
        unsigned xr[18], br[18], cr[18]; float dtr0 = 0.f, dtr1 = 0.f;
#define SSD_PREFETCH(chn) do { SSD_GEOM(chn) \
            if (wave == 0) { const int pos0 = d ? p0 + 127 - 2 * lane : p0 + 2 * lane, pos1 = d ? pos0 - 1 : pos0 + 1; \
                dtr0 = DT[(size_t)(rowbase + pos0) * 8 + d * 4 + hd]; dtr1 = DT[(size_t)(rowbase + pos1) * 8 + d * 4 + hd]; } \
            const int pw = p0 + 16 * wave - 1; const bool z_lo = (pw < 0), z_hi = (pw + 17 >= Ls); \
            const bf16* pl = PR + (size_t)rowbase * NPR + C_XBC; \
            _Pragma("unroll") for (int k = 0; k < 18; ++k) { const int pos = min(max(pw + k, 0), Ls - 1); const bf16* pp = pl + (size_t)pos * NPR; \
                xr[k] = (unsigned)pp[xix]; br[k] = *(const unsigned*)(pp + xib); cr[k] = *(const unsigned*)(pp + xic); } \
            if (z_lo) { xr[0] = 0u; br[0] = 0u; cr[0] = 0u; } \
            if (z_hi) { xr[17] = 0u; br[17] = 0u; cr[17] = 0u; } } while (0)
        SSD_PREFETCH(0);
#pragma nounroll
        for (int ch = 0; ch < 18; ++ch) {
            SSD_GEOM(ch)
            (void)Ls; (void)sb;
            if (wave == 0) {
                const float dt0 = softplus_f(dtr0 + dtb), dt1 = softplus_f(dtr1 + dtb);
                const float la0 = dt0 * a, ps = la0 + dt1 * a;
                const float v = wave_scan_incl(ps, lane);
                const float base = v - ps;
                acum[2 * lane] = base + la0; acum[2 * lane + 1] = base + ps; dtv[2 * lane] = dt0; dtv[2 * lane + 1] = dt1;
                const float acT = __shfl(v, 63);
                scl[2 * lane] = dt0 * __expf(acT - (base + la0)); scl[2 * lane + 1] = dt1 * __expf(acT - (base + ps));
            }
            __syncthreads();
            { auto stage = [&](auto dc) {
                  constexpr int D = decltype(dc)::value;
                  unsigned px[4], pb0[4], pb1[4]; float xprev = 0.f, t0prev = 0.f, t1prev = 0.f;
                  const int i0b = (D ? 112 - 16 * wave : 16 * wave) * 2;
#pragma unroll
                  for (int k = 0; k < 16; ++k) {
                      const int li = 16 * wave + k, i = D ? 127 - li : li;
                      const float xa = silu_f(wx0 * bf2f(xr[k]) + wx1 * bf2f(xr[k + 1]) + wx2 * bf2f(xr[k + 2]) + bx);
                      const float b0 = silu_f(wb00 * bflo(br[k]) + wb01 * bflo(br[k + 1]) + wb02 * bflo(br[k + 2]) + bb0), b1 = silu_f(wb10 * bfhi(br[k]) + wb11 * bfhi(br[k + 1]) + wb12 * bfhi(br[k + 2]) + bb1);
                      const float c0 = silu_f(wc00 * bflo(cr[k]) + wc01 * bflo(cr[k + 1]) + wc02 * bflo(cr[k + 2]) + bc0), c1 = silu_f(wc10 * bfhi(cr[k]) + wc11 * bfhi(cr[k + 1]) + wc12 * bfhi(cr[k + 2]) + bc1);
                      const float sc = scl[i];
                      *(LAS unsigned*)(lb + SS_BM + i * SS_LD + lane * 4) = pack2(b0, b1);
                      *(LAS unsigned*)(lb + SS_CM + i * SS_LD + lane * 4) = pack2(c0, c1);
                      const float t0 = b0 * sc, t1 = b1 * sc;
                      if (k & 1) { const int q = (k >> 1) & 3; px[q] = D ? pack2(xa, xprev) : pack2(xprev, xa); pb0[q] = D ? pack2(t0, t0prev) : pack2(t0prev, t0); pb1[q] = D ? pack2(t1, t1prev) : pack2(t1prev, t1); }
                      else { xprev = xa; t0prev = t0; t1prev = t1; }
                      if ((k & 7) == 7) {
                          const int ob = i0b + (D ? 16 * (1 - (k >> 3)) : 16 * (k >> 3));
#define SSD_W1(base, P) *(LAS u32x4*)(lb + (base) + ob) = D ? (u32x4){P[3], P[2], P[1], P[0]} : (u32x4){P[0], P[1], P[2], P[3]}
                          SSD_W1(SS_XT + lane * SS_LD, px); SSD_W1(SS_BT + (2 * lane) * SS_LD, pb0); SSD_W1(SS_BT + (2 * lane + 1) * SS_LD, pb1);
#undef SSD_W1
                          __builtin_amdgcn_sched_barrier(0);
                      }
                  }
              };
              if (d) stage(IntC<1>{}); else stage(IntC<0>{}); }
            __syncthreads();
            if (ch + 1 < 18) SSD_PREFETCH(ch + 1);
            {
                const int lt = wave < 4 ? wave : 11 - wave;
                bf16x8 Cf[4];
#pragma unroll
                for (int kk = 0; kk < 4; ++kk) Cf[kk] = *(const LAS bf16x8*)(lb + SS_CM + (16 * lt + lq) * SS_LD + (32 * kk + 8 * g) * 2);
                if (!(L == 1 && ch < 2)) {
                f32x4 Ya[4];
#pragma unroll
                for (int pt = 0; pt < 4; ++pt) { Ya[pt] = (f32x4){0.f, 0.f, 0.f, 0.f};
                    bf16x8 Hf[4];
#pragma unroll
                    for (int kk = 0; kk < 4; ++kk) Hf[kk] = *(const LAS bf16x8*)(lb + SS_HS + (16 * pt + lq) * SS_LD + (32 * kk + 8 * g) * 2);
                    __builtin_amdgcn_sched_barrier(0);
#pragma unroll
                    for (int kk = 0; kk < 4; ++kk) Ya[pt] = __builtin_amdgcn_mfma_f32_16x16x32_bf16(Hf[kk], Cf[kk], Ya[pt], 0, 0, 0); }
                const int l = 16 * lt + lq; const float acl = acum[l], el = __expf(acl);
#pragma unroll
                for (int pt = 0; pt < 4; ++pt) Ya[pt] *= el;
#pragma nounroll
                for (int sc = 0; sc <= (lt >> 1); ++sc) {
                    f32x4 G0 = (f32x4){0.f, 0.f, 0.f, 0.f}, G1 = (f32x4){0.f, 0.f, 0.f, 0.f};
                    const int srow0 = 32 * sc + 8 * (lq >> 2) + (lq & 3);
                    { bf16x8 A0[4], A1[4];
#pragma unroll
                      for (int kk = 0; kk < 4; ++kk) { A0[kk] = *(const LAS bf16x8*)(lb + SS_BM + srow0 * SS_LD + (32 * kk + 8 * g) * 2); A1[kk] = *(const LAS bf16x8*)(lb + SS_BM + (srow0 + 4) * SS_LD + (32 * kk + 8 * g) * 2); }
                      __builtin_amdgcn_sched_barrier(0);
#pragma unroll
                      for (int kk = 0; kk < 4; ++kk) { G0 = __builtin_amdgcn_mfma_f32_16x16x32_bf16(A0[kk], Cf[kk], G0, 0, 0, 0); G1 = __builtin_amdgcn_mfma_f32_16x16x32_bf16(A1[kk], Cf[kk], G1, 0, 0, 0); } }
                    const int s0 = 32 * sc + 8 * g;
                    const f32x4 as0 = *(const LAS f32x4*)(acum + s0), as1 = *(const LAS f32x4*)(acum + s0 + 4), ds0 = *(const LAS f32x4*)(dtv + s0), ds1 = *(const LAS f32x4*)(dtv + s0 + 4);
                    float pv[8];
#pragma unroll
                    for (int e = 0; e < 4; ++e) { const int sA = s0 + e, sB = s0 + 4 + e;
                        float vA = G0[e] * __expf(acl - as0[e]) * ds0[e], vB = G1[e] * __expf(acl - as1[e]) * ds1[e];
                        vA = (sA == l) ? vA + dsk : vA; vB = (sB == l) ? vB + dsk : vB;
                        pv[e] = (sA <= l) ? vA : 0.f; pv[4 + e] = (sB <= l) ? vB : 0.f; }
                    u32x4 pw4; pw4.x = pack2(pv[0], pv[1]); pw4.y = pack2(pv[2], pv[3]); pw4.z = pack2(pv[4], pv[5]); pw4.w = pack2(pv[6], pv[7]);
                    const bf16x8 pfr = __builtin_bit_cast(bf16x8, pw4);
                    { bf16x8 Xf[4];
#pragma unroll
                      for (int pt = 0; pt < 4; ++pt) Xf[pt] = *(const LAS bf16x8*)(lb + SS_XT + (16 * pt + lq) * SS_LD + s0 * 2);
                      __builtin_amdgcn_sched_barrier(0);
#pragma unroll
                      for (int pt = 0; pt < 4; ++pt) Ya[pt] = __builtin_amdgcn_mfma_f32_16x16x32_bf16(Xf[pt], pfr, Ya[pt], 0, 0, 0); }
                }
                { const int pos = d ? p0 + 127 - l : p0 + l; bf16* yp = Yd + ((size_t)d * MT + rowbase + pos) * 256 + hd * 64 + 4 * g;
#pragma unroll
                  for (int pt = 0; pt < 4; ++pt) { u32x2 yw; yw.x = pack2_acc(Ya[pt][0], Ya[pt][1]); yw.y = pack2_acc(Ya[pt][2], Ya[pt][3]); *(u32x2*)(yp + 16 * pt) = yw; } }
                }
                const float dA = __expf(acum[127]);
#pragma unroll
                for (int pt = 0; pt < 4; ++pt) Hacc[pt] *= dA;
#pragma unroll
                for (int kk = 0; kk < 4; ++kk) {
                    bf16x8 Xf[4]; const bf16x8 Bf = *(const LAS bf16x8*)(lb + SS_BT + (16 * wave + lq) * SS_LD + (32 * kk + 8 * g) * 2);
#pragma unroll
                    for (int pt = 0; pt < 4; ++pt) Xf[pt] = *(const LAS bf16x8*)(lb + SS_XT + (16 * pt + lq) * SS_LD + (32 * kk + 8 * g) * 2);
                    __builtin_amdgcn_sched_barrier(0);
#pragma unroll
                    for (int pt = 0; pt < 4; ++pt) Hacc[pt] = __builtin_amdgcn_mfma_f32_16x16x32_bf16(Bf, Xf[pt], Hacc[pt], 0, 0, 0);
                }
            }
            __syncthreads();
#pragma unroll
            for (int pt = 0; pt < 4; ++pt) { u32x2 hw; hw.x = pack2_acc(Hacc[pt][0], Hacc[pt][1]); hw.y = pack2_acc(Hacc[pt][2], Hacc[pt][3]);
                *(LAS u32x2*)(lb + SS_HS + (16 * pt + lq) * SS_LD + (16 * wave + 4 * g) * 2) = hw; }
        }
#undef SSD_PREFETCH
#undef SSD_GEOM
        __syncthreads();
    }
}

constexpr int AW_WIN = 0, AW_CK = 73728, AW_CV = AW_CK + 32768, AW_RPB = AW_CV + 32768;
static_assert(AW_RPB + 4 * 465 * 4 <= LDSCTL_OFF, "attention LDS map");
__device__ __forceinline__ int aw_swzk(int key) { return (key & 7) ^ ((key >> 3) & 3); }
template <int L>
__device__ __forceinline__ void attn_phase(const Frame& F) {
    PHASE_IDS
    const bf16* PR = (const bf16*)(F.ws + WS_PRB); const bf16* VT = (const bf16*)(F.ws + WS_VT); bf16* O = (bf16*)(F.ws + WS_HB);
    LAS unsigned char* lb = F.lds;
    LAS float* rpbL = (LAS float*)(F.lds + AW_RPB);
    __syncthreads();
    for (int i = tid; i < 4 * 465; i += 512) rpbL[i] = inptr(F, I_RPB)[(size_t)L * 4 * 465 + i] * 1.44269504f;
    for (int item = F.bid; item < NB * 4 * 2; item += F.G) {
        const int b = item >> 3, h = (item >> 1) & 3, hf = item & 1;
        __syncthreads();
        int tv = wave * 64 + lane_id_fresh();
#pragma unroll
        for (int i = 0; i < 4; ++i) { const int p = tv + 512 * i;
            { const int key = p >> 3, ch = p & 7; *(LAS u32x4*)(lb + AW_CK + key * 128 + ((ch ^ aw_swzk(key)) << 4)) = *(const u32x4*)(PR + (size_t)(ML + b * 256 + key) * NPR + C_K + h * 64 + ch * 8); }
            { const int vq = p & 3, dim = (p >> 2) & 63, cc = p >> 8; *(LAS u32x4*)(lb + AW_CV + cc * 4096 + dim * 64 + ((vq ^ ((dim >> 2) & 3)) << 4)) = *(const u32x4*)(VT + (size_t)(b * 256 + h * 64 + dim) * VT_LD + cc * 32 + vq * 8); } }
        u32x4 pre[9];
#define AW_KPREF(srA_) do { _Pragma("unroll") for (int i_ = 0; i_ < 9; ++i_) { const int p_ = tv + 512 * i_, key_ = p_ >> 3, ch_ = p_ & 7; const int kr_ = min((srA_) + (key_ >> 6), 31); \
            pre[i_] = *(const u32x4*)(PR + (size_t)(b * 2048 + kr_ * 64 + (key_ & 63)) * NPR + C_K + h * 64 + ch_ * 8); } } while (0)
#define AW_VPREF(srA_, lo_, hi_) do { _Pragma("unroll") for (int i_ = (lo_); i_ < (hi_); ++i_) { const int p_ = tv + 512 * i_, vc_ = ((p_ >> 8) << 2) + (p_ & 3), dim_ = (p_ >> 2) & 63; \
            pre[i_] = *(const u32x4*)(VT + (size_t)(b * 256 + h * 64 + dim_) * VT_LD + 256 + (srA_) * 64 + vc_ * 8); } } while (0)
        AW_KPREF(min(max(16 * hf - 4, 0), 24));
#pragma nounroll
        for (int it = 0; it < 8; ++it) {
            const int r0 = 16 * hf + 2 * it, srA = min(max(r0 - 4, 0), 24);
            const int ln = lane_id_fresh(); const int qi = ln & 15, g = ln >> 4; tv = wave * 64 + ln;
            const int xk0 = 8 * (qi >> 2) + (qi & 3);
            const int r = r0 + (wave >> 2), j = wave & 3, sr = min(max(r - 4, 0), 24), roff = sr - srA;
            const int band0 = min(max(16 * j - 8, 0), 32);
            __syncthreads();
#pragma unroll
            for (int i = 0; i < 9; ++i) { const int p = tv + 512 * i, key = p >> 3, ch = p & 7; *(LAS u32x4*)(lb + AW_WIN + key * 128 + ((ch ^ aw_swzk(key)) << 4)) = pre[i]; }
            const int qrow = b * 2048 + r * 64 + 16 * j + qi;
            const bf16* qp = PR + (size_t)qrow * NPR + C_Q + h * 64 + 8 * g;
            const bf16x8 q0 = *(const bf16x8*)qp, q1 = *(const bf16x8*)(qp + 32);
            int kwa[2][2], kca[2][2];
#pragma unroll
            for (int t = 0; t < 2; ++t) { const int kw = roff * 64 + band0 + xk0 + 4 * t, swt = aw_swzk(kw), kc0 = xk0 + 4 * t, swc = aw_swzk(kc0);
                kwa[t][0] = AW_WIN + kw * 128 + ((g ^ swt) << 4); kwa[t][1] = AW_WIN + kw * 128 + (((g + 4) ^ swt) << 4);
                kca[t][0] = AW_CK + kc0 * 128 + ((g ^ swc) << 4); kca[t][1] = AW_CK + kc0 * 128 + (((g + 4) ^ swc) << 4); }
            f32x4 S[16][2];
#pragma unroll
            for (int cc = 0; cc < 16; ++cc) {
                const int c = (cc + 8) & 15;
                if (cc == 8) { __syncthreads(); }
#pragma unroll
                for (int t = 0; t < 2; ++t) {
                    const bf16x8 k0 = *(const LAS bf16x8*)(lb + ((c < 8) ? kwa[t][0] + c * 8192 : kca[t][0] + (c - 8) * 4096)), k1 = *(const LAS bf16x8*)(lb + ((c < 8) ? kwa[t][1] + c * 8192 : kca[t][1] + (c - 8) * 4096));
                    const f32x4 z = (f32x4){0.f, 0.f, 0.f, 0.f};
                    S[c][t] = __builtin_amdgcn_mfma_f32_16x16x32_bf16(k0, q0, z, 0, 0, 0); S[c][t] = __builtin_amdgcn_mfma_f32_16x16x32_bf16(k1, q1, S[c][t], 0, 0, 0);
                }
                if ((cc & 3) == 3) __builtin_amdgcn_sched_barrier(0);
            }
            AW_VPREF(srA, 0, 5);
            float mx = -3.0e38f, mxc = -3.0e38f;
            { const int cq = 16 * j + qi, scq = min(max(cq - 8, 0), 48);
              int bidx[8]; bool vld[8];
#pragma unroll
              for (int te = 0; te < 8; ++te) { const int kc = band0 + 8 * g + te; vld[te] = (kc >= scq) && (kc < scq + 16); bidx[te] = h * 465 + (sr - r + 7) * 31 + min(max(kc - cq + 15, 0), 30); }
#pragma unroll
              for (int c = 0; c < 16; ++c) {
                  if (c < 8) {
                      float rb[8];
#pragma unroll
                      for (int te = 0; te < 8; ++te) rb[te] = *(const volatile LAS float*)(rpbL + bidx[te] + c * 31);
#pragma unroll
                      for (int t = 0; t < 2; ++t)
#pragma unroll
                          for (int e = 0; e < 4; ++e) { const float sv = vld[t * 4 + e] ? __builtin_fmaf(S[c][t][e], 0.125f * 1.44269504f, rb[t * 4 + e]) : -3.0e38f; S[c][t][e] = sv; mx = fmaxf(mx, sv); }
                  } else {
#pragma unroll
                      for (int t = 0; t < 2; ++t)
#pragma unroll
                          for (int e = 0; e < 4; ++e) mxc = fmaxf(mxc, S[c][t][e]);
                  }
              } }
            mx = fmaxf(mx, mxc * (0.125f * 1.44269504f));
            mx = fmaxf(mx, __shfl_xor(mx, 16)); mx = fmaxf(mx, __shfl_xor(mx, 32));
            float sum = 0.f;
            bf16x8 pf[16];
#pragma unroll
            for (int c = 0; c < 16; ++c) {
                float pv[8];
#pragma unroll
                for (int t = 0; t < 2; ++t)
#pragma unroll
                    for (int e = 0; e < 4; ++e) { pv[t * 4 + e] = __builtin_amdgcn_exp2f(c < 8 ? S[c][t][e] - mx : __builtin_fmaf(S[c][t][e], 0.125f * 1.44269504f, -mx)); sum += pv[t * 4 + e]; }
                u32x4 w; w.x = pack2(pv[0], pv[1]); w.y = pack2(pv[2], pv[3]); w.z = pack2(pv[4], pv[5]); w.w = pack2(pv[6], pv[7]);
                pf[c] = __builtin_bit_cast(bf16x8, w);
            }
            sum += __shfl_xor(sum, 16); sum += __shfl_xor(sum, 32);
            AW_VPREF(srA, 5, 9);
            __syncthreads();
#pragma unroll
            for (int i = 0; i < 9; ++i) { const int p = tv + 512 * i, vc = ((p >> 8) << 2) + (p & 3), dim = (p >> 2) & 63; *(LAS u32x4*)(lb + AW_WIN + vc * 1024 + dim * 16) = pre[i]; }
            if (it + 1 < 8) AW_KPREF(min(max(r0 + 2 - 4, 0), 24));
            int vwa[4], vca[4];
#pragma unroll
            for (int dt = 0; dt < 4; ++dt) { const int dim = 16 * dt + qi; vwa[dt] = AW_WIN + (roff * 8 + (band0 >> 3) + g) * 1024 + dim * 16; vca[dt] = AW_CV + dim * 64 + ((g ^ ((dim >> 2) & 3)) << 4); }
            f32x4 Oa[4];
#pragma unroll
            for (int dt = 0; dt < 4; ++dt) Oa[dt] = (f32x4){0.f, 0.f, 0.f, 0.f};
#pragma unroll
            for (int cc = 0; cc < 16; ++cc) {
                const int c = (cc + 8) & 15;
                if (cc == 8) { __syncthreads(); }
#pragma unroll
                for (int dt = 0; dt < 4; ++dt) Oa[dt] = __builtin_amdgcn_mfma_f32_16x16x32_bf16(*(const LAS bf16x8*)(lb + ((c < 8) ? vwa[dt] + c * 8192 : vca[dt] + (c - 8) * 4096)), pf[c], Oa[dt], 0, 0, 0);
                if ((cc & 3) == 3) __builtin_amdgcn_sched_barrier(0);
            }
            const float inv = 1.0f / sum;
            bf16* op = O + (size_t)qrow * DM + 512 + h * 64 + 4 * g;
#pragma unroll
            for (int dt = 0; dt < 4; ++dt) { u32x2 w; w.x = pack2(Oa[dt][0] * inv, Oa[dt][1] * inv); w.y = pack2(Oa[dt][2] * inv, Oa[dt][3] * inv); *(u32x2*)(op + 16 * dt) = w; }
        }
#undef AW_KPREF
#undef AW_VPREF
        if (L == 0) {
            const int ln = lane_id_fresh(); const int qi = ln & 15, g = ln >> 4; const int xk0 = 8 * (qi >> 2) + (qi & 3);
            const int qrow = ML + b * 256 + 16 * (hf * 8 + wave) + qi;
            const bf16* qp = PR + (size_t)qrow * NPR + C_Q + h * 64 + 8 * g;
            const bf16x8 q0 = *(const bf16x8*)qp, q1 = *(const bf16x8*)(qp + 32);
            int kca[2][2], vca[4];
#pragma unroll
            for (int t = 0; t < 2; ++t) { const int kc0 = xk0 + 4 * t, swc = aw_swzk(kc0); kca[t][0] = AW_CK + kc0 * 128 + ((g ^ swc) << 4); kca[t][1] = AW_CK + kc0 * 128 + (((g + 4) ^ swc) << 4); }
#pragma unroll
            for (int dt = 0; dt < 4; ++dt) { const int dim = 16 * dt + qi; vca[dt] = AW_CV + dim * 64 + ((g ^ ((dim >> 2) & 3)) << 4); }
            f32x4 S[8][2]; float mx = -3.0e38f;
#pragma unroll
            for (int c = 0; c < 8; ++c)
#pragma unroll
                for (int t = 0; t < 2; ++t) {
                    const bf16x8 k0 = *(const LAS bf16x8*)(lb + kca[t][0] + c * 4096), k1 = *(const LAS bf16x8*)(lb + kca[t][1] + c * 4096);
                    const f32x4 z = (f32x4){0.f, 0.f, 0.f, 0.f};
                    S[c][t] = __builtin_amdgcn_mfma_f32_16x16x32_bf16(k0, q0, z, 0, 0, 0); S[c][t] = __builtin_amdgcn_mfma_f32_16x16x32_bf16(k1, q1, S[c][t], 0, 0, 0);
#pragma unroll
                    for (int e = 0; e < 4; ++e) { S[c][t][e] *= (0.125f * 1.44269504f); mx = fmaxf(mx, S[c][t][e]); } }
            mx = fmaxf(mx, __shfl_xor(mx, 16)); mx = fmaxf(mx, __shfl_xor(mx, 32));
            float sum = 0.f; f32x4 Oa[4];
#pragma unroll
            for (int dt = 0; dt < 4; ++dt) Oa[dt] = (f32x4){0.f, 0.f, 0.f, 0.f};
#pragma unroll
            for (int c = 0; c < 8; ++c) { float pv[8];
#pragma unroll
                for (int t = 0; t < 2; ++t)
#pragma unroll
                    for (int e = 0; e < 4; ++e) { pv[t * 4 + e] = __builtin_amdgcn_exp2f(S[c][t][e] - mx); sum += pv[t * 4 + e]; }
                u32x4 w; w.x = pack2(pv[0], pv[1]); w.y = pack2(pv[2], pv[3]); w.z = pack2(pv[4], pv[5]); w.w = pack2(pv[6], pv[7]);
                const bf16x8 pfc = __builtin_bit_cast(bf16x8, w);
#pragma unroll
                for (int dt = 0; dt < 4; ++dt) Oa[dt] = __builtin_amdgcn_mfma_f32_16x16x32_bf16(*(const LAS bf16x8*)(lb + vca[dt] + c * 4096), pfc, Oa[dt], 0, 0, 0); }
            sum += __shfl_xor(sum, 16); sum += __shfl_xor(sum, 32);
            const float inv = 1.0f / sum;
            bf16* op = O + (size_t)qrow * DM + 512 + h * 64 + 4 * g;
#pragma unroll
            for (int dt = 0; dt < 4; ++dt) { u32x2 w; w.x = pack2(Oa[dt][0] * inv, Oa[dt][1] * inv); w.y = pack2(Oa[dt][2] * inv, Oa[dt][3] * inv); *(u32x2*)(op + 16 * dt) = w; }
        }
    }
    __syncthreads();
}
constexpr int PC_P_OFF = 48 * 256 * 4, PC_P_LD = 528;
template <int L>
__device__ __forceinline__ void poolconv_mfma(const Frame& F, int nrows) {
    PHASE_IDS
    const bf16* PR = (const bf16*)(F.ws + WS_PRB);
    bf16* O = (bf16*)(F.ws + WS_HB);
    LAS float* ut = (LAS float*)F.lds;
    LAS unsigned char* pl = F.lds + PC_P_OFF;
    const float* pw = inptr(F, I_POOLW) + (size_t)L * 4 * 64 * 64; const float* psc = inptr(F, I_POOLS) + L * 256; const float* cw = inptr(F, I_CONVW) + (size_t)L * 3 * 256;
    const int lq = lane & 15, g4 = lane >> 4, grp = wave & 3, tt = wave >> 2;
    bf16x8 Wf[4][2]; f32x4 scl[4];
#pragma unroll
    for (int nt = 0; nt < 4; ++nt) {
#pragma unroll
        for (int kk = 0; kk < 2; ++kk) { float w8[8];
#pragma unroll
            for (int e = 0; e < 8; ++e) w8[e] = pw[(grp * 64 + 32 * kk + 8 * g4 + e) * 64 + 16 * nt + lq];
            u32x4 pk; pk.x = pack2(w8[0], w8[1]); pk.y = pack2(w8[2], w8[3]); pk.z = pack2(w8[4], w8[5]); pk.w = pack2(w8[6], w8[7]); Wf[nt][kk] = __builtin_bit_cast(bf16x8, pk); }
        scl[nt] = *(const f32x4*)(psc + grp * 64 + 16 * nt + 4 * g4);
    }
    const int cp = tid & 127, seg = tid >> 7;
    const float cw00 = cw[2 * cp], cw01 = cw[256 + 2 * cp], cw02 = cw[512 + 2 * cp], cw10 = cw[2 * cp + 1], cw11 = cw[256 + 2 * cp + 1], cw12 = cw[512 + 2 * cp + 1];
    unsigned uw[12], hr[10], cr[10], bg[8];
#define PC_GEOM(item_) const int m0 = (item_) * 32; const bool lat = m0 < ML; const int Ls = lat ? 2048 : 256; const int seq0 = lat ? (m0 & ~2047) : ML + ((m0 - ML) & ~255); const int t0 = m0 - seq0;
#define PC_LOAD(item_) do { PC_GEOM(item_) \
        _Pragma("unroll") for (int it = 0; it < 12; ++it) { const int rr = it * 4 + seg, t = t0 - 8 + rr; uw[it] = 0u; if (t >= 0 && t < Ls) uw[it] = *(const unsigned*)(PR + (size_t)(seq0 + t) * NPR + C_POOL + 2 * cp); } \
        const int tb = t0 + 8 * seg - 1; \
        _Pragma("unroll") for (int k = 0; k < 10; ++k) { const int t = tb + k; const bool ok = (t >= 0) && (t < Ls); const bf16* pp = PR + (size_t)(seq0 + (ok ? t : 0)) * NPR + 2 * cp; \
            hr[k] = ok ? *(const unsigned*)(pp + C_CONVH) : 0u; cr[k] = ok ? *(const unsigned*)(pp + C_CONVC) : 0u; if (k >= 1 && k <= 8) bg[k - 1] = *(const unsigned*)(pp + C_CONVB); } } while (0)
    if (F.bid < nrows / 32) PC_LOAD(F.bid);
    for (int item = F.bid; item < nrows / 32; item += F.G) {
        PC_GEOM(item)
        (void)lat;
        __syncthreads();
#pragma unroll
        for (int it = 0; it < 12; ++it) { const int rr = it * 4 + seg; ut[rr * 256 + 2 * cp] = bflo(uw[it]); ut[rr * 256 + 2 * cp + 1] = bfhi(uw[it]); }
        { float p0[10], p1[10];
#pragma unroll
          for (int k = 0; k < 10; ++k) { p0[k] = bflo(hr[k]) * bflo(cr[k]); p1[k] = bfhi(hr[k]) * bfhi(cr[k]); }
#pragma unroll
          for (int k = 0; k < 8; ++k) { const float y0 = bflo(bg[k]) * (cw00 * p0[k] + cw01 * p0[k + 1] + cw02 * p0[k + 2]), y1 = bfhi(bg[k]) * (cw10 * p1[k] + cw11 * p1[k + 1] + cw12 * p1[k + 2]);
              *(unsigned*)(O + (size_t)(m0 + 8 * seg + k) * DM + 256 + 2 * cp) = pack2(y0, y1); } }
        if (item + F.G < nrows / 32) PC_LOAD(item + F.G);
        __syncthreads();
        { const int c = tid & 255, sg = tid >> 8, gg = c >> 6, hw = 1 << gg;
          int t = t0 + 16 * sg; float S = 0.f;
          for (int q = -hw; q < hw; ++q) S += ut[(16 * sg + 8 + q) * 256 + c];
#pragma unroll 4
          for (int i = 0; i < 16; ++i, ++t) { const int rr = 16 * sg + i + 8;
              const int cnt = min(t + hw, Ls) - max(t - hw, 0);
              *(LAS bf16*)(pl + (16 * sg + i) * PC_P_LD + c * 2) = f2bf(S / (float)cnt - ut[rr * 256 + c]);
              S += ut[(rr + hw) * 256 + c] - ut[(rr - hw) * 256 + c]; } }
        __syncthreads();
        { const bf16x8 B0 = *(const LAS bf16x8*)(pl + (16 * tt + lq) * PC_P_LD + (grp * 64 + 8 * g4) * 2), B1 = *(const LAS bf16x8*)(pl + (16 * tt + lq) * PC_P_LD + (grp * 64 + 32 + 8 * g4) * 2);
          bf16* op = O + (size_t)(m0 + 16 * tt + lq) * DM + grp * 64 + 4 * g4;
#pragma unroll
          for (int nt = 0; nt < 4; ++nt) { f32x4 D = (f32x4){0.f, 0.f, 0.f, 0.f};
              D = __builtin_amdgcn_mfma_f32_16x16x32_bf16(Wf[nt][0], B0, D, 0, 0, 0); D = __builtin_amdgcn_mfma_f32_16x16x32_bf16(Wf[nt][1], B1, D, 0, 0, 0);
              D *= scl[nt]; u32x2 w; w.x = pack2(D[0], D[1]); w.y = pack2(D[2], D[3]); *(u32x2*)(op + 16 * nt) = w; } }
    }
    __syncthreads();
#undef PC_LOAD
#undef PC_GEOM
}
template <int L>
__device__ __forceinline__ void ssd_combine(const Frame& F, const bf16* Yd, int nrows) {
    PHASE_IDS
    const bf16* PR = (const bf16*)(F.ws + WS_PRB);
    bf16* O = (bf16*)(F.ws + WS_HB);
    const f32x4 ng = *(const f32x4*)(inptr(F, I_SNG) + L * 256 + lane * 4);
    for (int m = F.bid * 8 + wave; m < nrows; m += F.G * 8) {
        const u32x2 y0w = *(const u32x2*)(Yd + (size_t)m * 256 + lane * 4), y1w = *(const u32x2*)(Yd + ((size_t)MT + m) * 256 + lane * 4);
        const f32x4 y0 = (f32x4){bflo(y0w.x), bfhi(y0w.x), bflo(y0w.y), bfhi(y0w.y)}, y1 = (f32x4){bflo(y1w.x), bfhi(y1w.x), bflo(y1w.y), bfhi(y1w.y)};
        const u32x2 zw = *(const u32x2*)(PR + (size_t)m * NPR + C_Z + lane * 4);
        f32x4 v; v[0] = (y0[0] + y1[0]) * silu_f(bflo(zw.x)); v[1] = (y0[1] + y1[1]) * silu_f(bfhi(zw.x)); v[2] = (y0[2] + y1[2]) * silu_f(bflo(zw.y)); v[3] = (y0[3] + y1[3]) * silu_f(bfhi(zw.y));
        const float ss = wave_sum(v[0] * v[0] + v[1] * v[1] + v[2] * v[2] + v[3] * v[3]);
        const float rstd = rsqrtf(ss * (1.0f / 256.0f) + EPS);
        u32x2 w; w.x = pack2(v[0] * rstd * ng[0], v[1] * rstd * ng[1]); w.y = pack2(v[2] * rstd * ng[2], v[3] * rstd * ng[3]);
        *(u32x2*)(O + (size_t)m * DM + 768 + lane * 4) = w;
    }
}
__device__ __forceinline__ void final_phase(const Frame& F) {
    PHASE_IDS
    const bf16* XR = (const bf16*)(F.ws + WS_XR);
    const bf16* Y = (const bf16*)F.out;
    const float* mod = (const float*)(F.ws + WS_MOD) + (size_t)1 * 33 * 6144 + 5 * 1024;
    const float* gfin = inptr(F, I_GFINAL);
    const int per = (ML + F.G * 8 - 1) / (F.G * 8), mbeg = (F.bid * 8 + wave) * per, mend = min(mbeg + per, ML);
    u32x2 xw[4], ya[4], yb[4], xwn[4], yan[4], ybn[4];
    f32x4 gfv[4];
#pragma unroll
    for (int j = 0; j < 4; ++j) gfv[j] = *(const f32x4*)(gfin + j * 256 + lane * 4);
#define FP_LOAD(m, XW, YA, YB) do { _Pragma("unroll") for (int j = 0; j < 4; ++j) { const int e = j * 256 + lane * 4; XW[j] = *(const GAS u32x2*)((const GAS bf16*)XR + (size_t)(m) * DM + e); \
        YA[j] = *(const GAS u32x2*)((const GAS bf16*)Y + (size_t)(2 * (m)) * DM + e); YB[j] = *(const GAS u32x2*)((const GAS bf16*)Y + (size_t)(2 * (m) + 1) * DM + e); } } while (0)
    if (mbeg < mend) FP_LOAD(mbeg, xw, ya, yb);
    for (int m = mbeg; m < mend; ++m) {
        if (m + 1 < mend) FP_LOAD(m + 1, xwn, yan, ybn);
        const float* grow = mod + (size_t)(m >> 11) * 6144;
        f32x4 v[4]; float ss = 0.f;
#pragma unroll
        for (int j = 0; j < 4; ++j) { const int e = j * 256 + lane * 4; const f32x4 g = *(const f32x4*)(grow + e);
            v[j][0] = bflo(xw[j].x) + g[0] * (bflo(ya[j].x) + bflo(yb[j].x)); v[j][1] = bfhi(xw[j].x) + g[1] * (bfhi(ya[j].x) + bfhi(yb[j].x));
            v[j][2] = bflo(xw[j].y) + g[2] * (bflo(ya[j].y) + bflo(yb[j].y)); v[j][3] = bfhi(xw[j].y) + g[3] * (bfhi(ya[j].y) + bfhi(yb[j].y));
            ss += v[j][0] * v[j][0] + v[j][1] * v[j][1] + v[j][2] * v[j][2] + v[j][3] * v[j][3]; }
        ss = wave_sum(ss);
        const float rstd = rsqrtf(ss * (1.0f / DM) + EPS);
#pragma unroll
        for (int j = 0; j < 4; ++j) { const int e = j * 256 + lane * 4; *(f32x4*)(F.out + (size_t)m * DM + e) = v[j] * rstd * gfv[j]; }
#pragma unroll
        for (int j = 0; j < 4; ++j) { xw[j] = xwn[j]; ya[j] = yan[j]; yb[j] = ybn[j]; }
    }
#undef FP_LOAD
}

constexpr int N_PHASES = 19;
#ifndef DUP
#define DUP 0
#endif
__global__ void __launch_bounds__(512, 2) fwd_kernel(Args args) {
    extern __shared__ __attribute__((aligned(16))) unsigned char lds_raw[];
    Frame F;
    F.lds = (LAS unsigned char*)lds_raw;
    F.G = gridDim.x; F.bid = blockIdx.x; F.wv = __builtin_amdgcn_readfirstlane(threadIdx.x >> 6);
    F.out = args.out; F.ws = args.ws;
    volatile LAS unsigned* ctlw = (volatile LAS unsigned*)(F.lds + LDSCTL_OFF);
    if (threadIdx.x < 4) ctlw[threadIdx.x] = 0u;
    { volatile LAS unsigned long long* tbl = (volatile LAS unsigned long long*)(F.lds + LDSCTL_OFF + 16);
#pragma unroll
      for (int i = 0; i < 26; ++i) if (threadIdx.x == 64 + i) tbl[i] = (unsigned long long)args.in[i]; }
    __syncthreads();
    const int lo = args.ph_lo, hi = args.ph_hi;
    const bool multi = (hi - lo) > 1;
    XcdBarrier bar; bar.bar = (unsigned*)(F.ws + WS_CTL) + CW_BAR; bar.x = 0; bar.st = ctlw;
    if (multi) bar = xcd_barrier_post((unsigned*)(F.ws + WS_CTL) + CW_BAR, ctlw);
#define IN(k) (lo <= (k) && (k) < hi)
#define SEAM(k) do { if (IN((k) + 1)) xcd_barrier(bar, F.wv); } while (0)
    unsigned char* wb = F.ws + WS_WB;
    bf16* HB = (bf16*)(F.ws + WS_HB); bf16* PRB = (bf16*)(F.ws + WS_PRB);
    const float* MOD = (const float*)(F.ws + WS_MOD);
    bf16* Yd = (bf16*)F.out;

    if (IN(0)) { p0_prologue(F); SEAM(0); }
    if (IN(1)) { conv_tiles(F, 0, 704, 0, 0, F.bid, F.G); norm_phase<0, 6, false, false>(F, MT, nullptr, nullptr); SEAM(1); }
    if (IN(2)) { pg8::DenseOrderT<true> S; S.init(MT, NPR, F.G, F.bid); pg8::EpiInProjI8 E{PRB, (bf16*)(F.ws + WS_VT), (const float*)(F.ws + WS_RS), (const float*)(F.ws + WS_CSIN)};
        pg8::gemm_phase<pg8::EpiInProjI8, pg8::DenseOrderT<true>, 2>(F.lds, F.wv, HB, (const bf16*)(wb + WB_IN), DM / 2, S, E);
        { int w, nw; if (tail_worker(F, (MT / 256) * (NPR / 256), w, nw)) conv_tiles(F, 1408, 256, 1920, 1408, w, nw); }
        SEAM(2); }
    if (IN(3)) { ssd_scan_mfma<0>(F, Yd); attn_phase<0>(F); poolconv_mfma<0>(F, MT); SEAM(3); }
    if (IN(4)) { ssd_combine<0>(F, Yd, MT); SEAM(4); }
    if (IN(5)) { pg8::DenseOrder S; S.init(MT, DM, F.G, F.bid); pg8::EpiResid<true> E{(bf16*)(F.ws + WS_XR), inptr(F, I_X), inptr(F, I_CTX), MOD + 2 * 1024};
        pg8::gemm_phase(F.lds, F.wv, HB, (const bf16*)(wb + WB_OUT), DM, S, E);
        { int w, nw; if (tail_worker(F, (MT / 256) * (DM / 256), w, nw)) conv_tiles(F, 3328, 704, 704, 704, w, nw); }
        SEAM(5); }
    if (IN(6)) { norm_phase<0, 5, true, false>(F, MT, nullptr, nullptr); SEAM(6); }
    if (IN(7)) { pg8::DenseOrderT<true> S; S.init(MT, 2 * DFF, F.G, F.bid); pg8::EpiSwigluI8 E{PRB, DFF, (const float*)(F.ws + WS_RS), (const float*)(F.ws + WS_CS), DFF};
        pg8::gemm_phase<pg8::EpiSwigluI8, pg8::DenseOrderT<true>, 2>(F.lds, F.wv, HB, (const bf16*)(wb + WB_GU), DM / 2, S, E);
        { int w, nw; if (tail_worker(F, (MT / 256) * (2 * DFF / 256), w, nw)) conv_tiles(F, 1664, 256, 0, 0, w, nw); }
        SEAM(7); }
    if (IN(8)) { pg8::DenseOrder S; S.init(MT, DM, F.G, F.bid); pg8::EpiResid<false> E{(bf16*)(F.ws + WS_XR), nullptr, nullptr, MOD + 5 * 1024};
        pg8::gemm_phase(F.lds, F.wv, PRB, (const bf16*)(wb + WB_DOWN), DFF, S, E);
        { int w, nw; if (tail_worker(F, (MT / 256) * (DM / 256), w, nw)) conv_tiles(F, 4032, 8448, 0, 0, w, nw); }
        SEAM(8); }
    if (IN(9)) { norm_phase<1, 6, true, false>(F, MT, nullptr, nullptr); SEAM(9); }
    if (IN(10)) { pg8::InProjL1OrderT<true> S; S.init(F.G, F.bid); pg8::EpiInProjI8 E{PRB, (bf16*)(F.ws + WS_VT), (const float*)(F.ws + WS_RS), (const float*)(F.ws + WS_CSIN) + NPR};
        pg8::gemm_phase<pg8::EpiInProjI8, pg8::InProjL1OrderT<true>, 2>(F.lds, F.wv, HB, (const bf16*)(wb + WB_IN + WB_IN_SZ), DM / 2, S, E); SEAM(10); }
    if (IN(11)) { ssd_scan_mfma<1>(F, Yd); attn_phase<1>(F); poolconv_mfma<1>(F, ML); SEAM(11); }
    if (IN(12)) { ssd_combine<1>(F, Yd, ML); SEAM(12); }
    if (IN(13)) { pg8::DenseOrder S; S.init(ML, DM, F.G, F.bid); pg8::EpiResid<false> E{(bf16*)(F.ws + WS_XR), nullptr, nullptr, MOD + 33 * 6144 + 2 * 1024};
        pg8::gemm_phase(F.lds, F.wv, HB, (const bf16*)(wb + WB_OUT + WB_OUT_SZ), DM, S, E); SEAM(13); }
    if (IN(14)) { norm_phase<1, 2, true, false>(F, ML, nullptr, nullptr); SEAM(14); }
    if (IN(16)) { pg8::MoeOrder<true> S; S.init((const unsigned*)(F.ws + WS_CTL) + CW_CNT, (const int*)(F.ws + WS_LISTE), WB_MGU_SZ, 2 * DFE, F.G, F.bid); pg8::EpiSwigluF8 E{F.ws + WS_PRB};
        pg8::gemm_phase<pg8::EpiSwigluF8, pg8::MoeOrder<true>, 1>(F.lds, F.wv, HB, (const bf16*)(wb + WB_MGU), DM / 2, S, E); SEAM(16); }
    if (IN(17)) { pg8::MoeOrder<false, true> S; S.init((const unsigned*)(F.ws + WS_CTL) + CW_CNT, (const int*)(F.ws + WS_LISTE), WB_MDOWN_SZ, DM, F.G, F.bid);
        pg8::EpiMoeOut E{(bf16*)F.out, (const int*)(F.ws + WS_LISTE), (const float*)(F.ws + WS_ROUTE) + 4 * ML};
        pg8::gemm_phase<pg8::EpiMoeOut, pg8::MoeOrder<false, true>, 1>(F.lds, F.wv, PRB, (const bf16*)(wb + WB_MDOWN), DFEP / 2, S, E); SEAM(17); }
    if (IN(18)) { final_phase(F); }
#undef IN
#undef SEAM
}

#ifndef N_LAUNCHES
#define N_LAUNCHES 1
#endif
extern "C" void kernel_launch(void* const* d_in, const int* in_sizes, int n_in, void* d_out, int out_size, void* d_ws, size_t ws_size, hipStream_t stream) {
    static int grid = 0;
    if (grid == 0) {
        if (n_in != 26 || out_size != ML * DM || ws_size < WS_END) { fprintf(stderr, "kernel_launch: unexpected shapes: n_in %d out %d ws %zu\n", n_in, out_size, ws_size); grid = -1; return; }
        int dev = 0, cus = 0, per_cu = 0;
        if (hipGetDevice(&dev) != hipSuccess || hipDeviceGetAttribute(&cus, hipDeviceAttributeMultiprocessorCount, dev) != hipSuccess) { grid = -1; return; }
        if (hipFuncSetAttribute((const void*)fwd_kernel, hipFuncAttributeMaxDynamicSharedMemorySize, LDS_BYTES) != hipSuccess) { fprintf(stderr, "kernel_launch: hipFuncSetAttribute failed\n"); grid = -1; return; }
        if (hipOccupancyMaxActiveBlocksPerMultiprocessor(&per_cu, (const void*)fwd_kernel, 512, LDS_BYTES) != hipSuccess || per_cu < 1) { fprintf(stderr, "kernel_launch: occupancy query says %d\n", per_cu); (void)hipGetLastError(); per_cu = 1; }
        grid = cus;
    }
    if (grid < 0) return;
    (void)hipMemsetAsync((char*)d_ws + WS_CTL, 0, 64 * 1024, stream);
    Args a{};
    for (int i = 0; i < 26; ++i) a.in[i] = (const float*)d_in[i];
    a.out = (float*)d_out; a.ws = (unsigned char*)d_ws;
    if (N_LAUNCHES == 1) { a.ph_lo = 0; a.ph_hi = N_PHASES; hipLaunchKernelGGL(fwd_kernel, dim3(grid), dim3(512), LDS_BYTES, stream, a); }
    else { for (int p = 0; p < N_PHASES; ++p) { a.ph_lo = p; a.ph_hi = p + 1; hipLaunchKernelGGL(fwd_kernel, dim3(grid), dim3(512), LDS_BYTES, stream, a); } }
}
```

```cpp
#include <hip/hip_runtime.h>
#include <cstdio>
#include <cstdint>

#define LAS __attribute__((address_space(3)))
#define GAS __attribute__((address_space(1)))
typedef unsigned short bf16;
typedef short bf16x8 __attribute__((ext_vector_type(8)));
typedef float f32x4 __attribute__((ext_vector_type(4)));
typedef unsigned u32x4 __attribute__((ext_vector_type(4)));
typedef unsigned u32x2 __attribute__((ext_vector_type(2)));
typedef int i32x4 __attribute__((ext_vector_type(4)));
typedef int i32x8 __attribute__((ext_vector_type(8)));

constexpr int DM = 1024, NB = 32, SEQ = 2048, CTXL = 256, GRIDW = 64;
constexpr int ML = NB * SEQ;
constexpr int MC = NB * CTXL;
constexpr int MT = ML + MC;
constexpr int NPR = 2816;
constexpr int DIN = 2824;
constexpr int DFF = 2816, DFE = 1408, NEXP = 8;
constexpr int MOE_ROWS = 2 * ML + NEXP * 256;
constexpr float EPS = 1e-6f;
constexpr int C_POOL = 0, C_CONVH = 256, C_CONVB = 512, C_CONVC = 768, C_Q = 1024, C_K = 1280, C_V = 1536, C_Z = 1792, C_XBC = 2048;

constexpr size_t MiB = 1u << 20;
constexpr size_t WS_CTL = 0, CTL_BYTES = 1 * MiB;
constexpr size_t WS_MOD = 1 * MiB;
constexpr size_t WS_ROUTE = 3 * MiB;
constexpr size_t WS_ROWTOK = 5 * MiB;
constexpr size_t WS_WB = 8 * MiB;
constexpr size_t WS_XR = 106 * MiB;
constexpr size_t WS_HB = 394 * MiB;
constexpr size_t WS_PRB = 538 * MiB;
constexpr size_t WS_DT = 934 * MiB;
constexpr size_t WS_VT = 937 * MiB;
constexpr int VT_LD = 2304;
constexpr size_t WS_LISTE = 976 * MiB;
constexpr size_t WS_END = 1024 * MiB;
constexpr size_t WB_IN = 0, WB_IN_SZ = (size_t)NPR * DM * 2;
constexpr size_t WB_OUT = 2 * WB_IN_SZ, WB_OUT_SZ = (size_t)DM * DM * 2;
constexpr size_t WB_GU = WB_OUT + 2 * WB_OUT_SZ, WB_GU_SZ = (size_t)2 * DFF * DM * 2;
constexpr size_t WS_RS = WS_ROUTE;
constexpr size_t WS_CS = WS_ROWTOK;
constexpr size_t WS_CSIN = 6 * MiB;
constexpr size_t WB_DOWN = WB_GU + WB_GU_SZ, WB_DOWN_SZ = (size_t)DM * DFF * 2;
constexpr int DFEP = 1536;
constexpr float W8S = 32.f, H8S = 4.f;
constexpr size_t WB_MGU = WB_DOWN + WB_DOWN_SZ, WB_MGU_SZ = (size_t)2 * DFE * DM;
constexpr size_t WB_MDOWN = WB_MGU + NEXP * WB_MGU_SZ, WB_MDOWN_SZ = (size_t)DM * DFEP;
static_assert(WB_MDOWN + NEXP * WB_MDOWN_SZ <= 98 * MiB, "weights fit");
constexpr int CW_CNT = 512;
constexpr int CW_POFF = 128;
constexpr int CW_BAR = 4096;

constexpr int LDS_BYTES = 147456;
constexpr int LDSCTL_OFF = LDS_BYTES - 256;

__device__ __forceinline__ float bf2f(unsigned v) { return __uint_as_float(v << 16); }
__device__ __forceinline__ float bflo(unsigned w) { return __uint_as_float(w << 16); }
__device__ __forceinline__ float bfhi(unsigned w) { return __uint_as_float(w & 0xFFFF0000u); }
__device__ __forceinline__ unsigned pack2(float lo, float hi) { unsigned r; asm volatile("v_cvt_pk_bf16_f32 %0, %1, %2" : "=v"(r) : "v"(lo), "v"(hi)); return r; }
typedef __bf16 hwbf16x2 __attribute__((ext_vector_type(2)));
typedef float f32x2_ __attribute__((ext_vector_type(2)));
__device__ __forceinline__ unsigned pack2_acc(float lo, float hi) { return __builtin_bit_cast(unsigned, __builtin_convertvector((f32x2_){lo, hi}, hwbf16x2)); }
__device__ __forceinline__ bf16 f2bf(float f) { return (bf16)(pack2(f, 0.f) & 0xFFFFu); }
__device__ __forceinline__ unsigned pack4_fp8(float a, float b, float c, float d) {
    a = fminf(fmaxf(a, -448.f), 448.f); b = fminf(fmaxf(b, -448.f), 448.f); c = fminf(fmaxf(c, -448.f), 448.f); d = fminf(fmaxf(d, -448.f), 448.f);
    int w = 0; w = __builtin_amdgcn_cvt_pk_fp8_f32(a, b, w, false); w = __builtin_amdgcn_cvt_pk_fp8_f32(c, d, w, true); return (unsigned)w;
}
__device__ __forceinline__ float silu_f(float v) { return v * __builtin_amdgcn_rcpf(1.0f + __expf(-v)); }
__device__ __forceinline__ float softplus_f(float v) { return v > 20.f ? v : log1pf(__expf(v)); }
__device__ __forceinline__ float dpp_f(float v, const int ctrl_sel) {
    const int x = __float_as_int(v); int r;
    if (ctrl_sel == 0) r = __builtin_amdgcn_update_dpp(x, x, 0xB1, 0xF, 0xF, false);
    else if (ctrl_sel == 1) r = __builtin_amdgcn_update_dpp(x, x, 0x4E, 0xF, 0xF, false);
    else if (ctrl_sel == 2) r = __builtin_amdgcn_update_dpp(x, x, 0x141, 0xF, 0xF, false);
    else r = __builtin_amdgcn_update_dpp(x, x, 0x140, 0xF, 0xF, false);
    return __int_as_float(r);
}
__device__ __forceinline__ float row8_sum(float v) { v += dpp_f(v, 0); v += dpp_f(v, 1); v += dpp_f(v, 2); return v; }
__device__ __forceinline__ float wave_sum(float v) {
    v = row8_sum(v); v += dpp_f(v, 3);
    const float s0 = __int_as_float(__builtin_amdgcn_readlane(__float_as_int(v), 0)), s1 = __int_as_float(__builtin_amdgcn_readlane(__float_as_int(v), 16)),
                s2 = __int_as_float(__builtin_amdgcn_readlane(__float_as_int(v), 32)), s3 = __int_as_float(__builtin_amdgcn_readlane(__float_as_int(v), 48));
    return (s0 + s1) + (s2 + s3);
}
__device__ __forceinline__ float wave_scan_incl(float v, const int lane) {
#define WS_SHR(c) __int_as_float(__builtin_amdgcn_update_dpp(0, __float_as_int(v), (c), 0xF, 0xF, false))
    v += WS_SHR(0x111); v += WS_SHR(0x112); v += WS_SHR(0x114); v += WS_SHR(0x118);
#undef WS_SHR
    const float t0 = __int_as_float(__builtin_amdgcn_readlane(__float_as_int(v), 15)), t1 = __int_as_float(__builtin_amdgcn_readlane(__float_as_int(v), 31)), t2 = __int_as_float(__builtin_amdgcn_readlane(__float_as_int(v), 47));
    return v + ((lane >= 16 ? t0 : 0.f) + (lane >= 32 ? t1 : 0.f)) + (lane >= 48 ? t2 : 0.f);
}
__device__ __forceinline__ float wave_max_dpp(float v) {
    v = fmaxf(v, dpp_f(v, 0)); v = fmaxf(v, dpp_f(v, 1)); v = fmaxf(v, dpp_f(v, 2)); v = fmaxf(v, dpp_f(v, 3));
    const float s0 = __int_as_float(__builtin_amdgcn_readlane(__float_as_int(v), 0)), s1 = __int_as_float(__builtin_amdgcn_readlane(__float_as_int(v), 16)),
                s2 = __int_as_float(__builtin_amdgcn_readlane(__float_as_int(v), 32)), s3 = __int_as_float(__builtin_amdgcn_readlane(__float_as_int(v), 48));
    return fmaxf(fmaxf(s0, s1), fmaxf(s2, s3));
}
__device__ __forceinline__ unsigned pack4_i8(float a, float b, float c, float d) {
    const int ia = __float2int_rn(a), ib = __float2int_rn(b), ic = __float2int_rn(c), id = __float2int_rn(d);
    return (unsigned)(ia & 255) | ((unsigned)(ib & 255) << 8) | ((unsigned)(ic & 255) << 16) | ((unsigned)(id & 255) << 24);
}
__device__ __forceinline__ float wave_max(float v) {
#pragma unroll
    for (int o = 32; o >= 1; o >>= 1) v = fmaxf(v, __shfl_xor(v, o));
    return v;
}
__device__ __forceinline__ int lane_id_fresh() { int l; asm volatile("v_mbcnt_lo_u32_b32 %0, -1, 0\n\tv_mbcnt_hi_u32_b32 %0, -1, %0" : "=v"(l)); return l; }
__device__ __forceinline__ int modidx_of(int m) { return m < ML ? (m >> 11) : 32; }

#define XB_TMO      128
#define XB_XCNT(j)  (256  + 64 * (j))
#define XB_XSUB(j)  (1280 + 64 * (j))
#define XB_XGEN(j)  (2304 + 64 * (j))
#define XB_TOP      3328
#define XB_TOPGEN   3392
#define XCD_BAR_WORDS 3456
#define XB_SPIN_CAP (1u << 22)
__device__ __forceinline__ unsigned xb_ld(unsigned* p)              { return __hip_atomic_load(p, __ATOMIC_RELAXED, __HIP_MEMORY_SCOPE_AGENT); }
__device__ __forceinline__ unsigned xb_add(unsigned* p, unsigned v) { return __hip_atomic_fetch_add(p, v, __ATOMIC_RELAXED, __HIP_MEMORY_SCOPE_AGENT); }
__device__ __forceinline__ unsigned xb_xcc_id() { return (unsigned)__builtin_amdgcn_s_getreg((3 << 11) | 20) & 0xFu; }
#define XB_SPIN(cond, bar) do { unsigned _sp = 0; while (cond) { __builtin_amdgcn_s_sleep(1); \
    if ((++_sp & 255u) == 0u) { if (xb_ld(&(bar)[XB_TMO])) break; if (_sp > XB_SPIN_CAP) { atomicAdd(&(bar)[XB_TMO], 1u); break; } } } } while (0)
struct XcdBarrier { unsigned* bar; unsigned x; volatile LAS unsigned* st; };
__device__ __forceinline__ XcdBarrier xcd_barrier_post(unsigned* bar, volatile LAS unsigned* st) {
    XcdBarrier b; b.bar = bar; b.x = xb_xcc_id(); b.st = st;
    if (threadIdx.x == 0) (void)xb_add(&bar[XB_XCNT(b.x)], 1u);
    return b;
}
__device__ __forceinline__ void xcd_barrier_complete(unsigned* bar, unsigned x, unsigned& nloc, unsigned& nx) {
    const unsigned G = gridDim.x * gridDim.y * gridDim.z;
    unsigned sum, cnt, mine, sp = 0u;
    for (;;) {
        sum = 0u; cnt = 0u; mine = 0u;
#pragma unroll
        for (unsigned j = 0; j < 16; ++j) { const unsigned c = xb_ld(&bar[XB_XCNT(j)]); sum += c; cnt += (c > 0u) ? 1u : 0u; mine = (j == x) ? c : mine; }
        if (sum == G) break;
        __builtin_amdgcn_s_sleep(1);
        if ((++sp & 255u) == 0u) { if (xb_ld(&bar[XB_TMO])) break; if (sp > XB_SPIN_CAP) { atomicAdd(&bar[XB_TMO], 1u); break; } }
    }
    nloc = mine > 0u ? mine : 1u; nx = cnt > 0u ? cnt : 1u;
}
__device__ __forceinline__ void xcd_barrier(const XcdBarrier& b, const int wv) {
    asm volatile("s_waitcnt vmcnt(0)" ::: "memory");
    __syncthreads();
    if (wv == 0 && lane_id_fresh() == 0) {
        unsigned* bar = b.bar;
        __builtin_amdgcn_s_waitcnt(0);
        unsigned nloc = b.st[0], nx = b.st[1];
        if (nloc == 0u) { xcd_barrier_complete(bar, b.x, nloc, nx); b.st[0] = nloc; b.st[1] = nx; }
        const unsigned old = xb_add(&bar[XB_XSUB(b.x)], 1u);
        const unsigned gen = old / nloc;
        if (old + 1u == (gen + 1u) * nloc) {
            __builtin_amdgcn_fence(__ATOMIC_RELEASE, "agent");
            asm volatile("s_waitcnt vmcnt(0)" ::: "memory");
            const unsigned og = xb_add(&bar[XB_TOP], 1u);
            const unsigned tg = og / nx;
            if (og + 1u == (tg + 1u) * nx) xb_add(&bar[XB_TOPGEN], 1u);
            else XB_SPIN(xb_ld(&bar[XB_TOPGEN]) == tg, bar);
            __builtin_amdgcn_fence(__ATOMIC_ACQUIRE, "agent");
            xb_add(&bar[XB_XGEN(b.x)], 1u);
            asm volatile("s_waitcnt vmcnt(0)" ::: "memory");
        } else {
            XB_SPIN(xb_ld(&bar[XB_XGEN(b.x)]) == gen, bar);
            __builtin_amdgcn_fence(__ATOMIC_ACQUIRE, "agent");
            asm volatile("s_waitcnt vmcnt(0)" ::: "memory");
        }
    }
    __syncthreads();
}

namespace pg8 {
constexpr int BM = 256, BK = 64, HALF = 128, HTB = HALF * BK * 2, STAGE_BYTES = 8 * HTB, NXCD = 8, WGM = 8;
__host__ __device__ __forceinline__ int lds_byte(int r, int c) { const int st = (r >> 4) * 2 + (c >> 5), rr = r & 15, cc = c & 31, ob = rr * 64 + cc * 2; return st * 1024 + (ob ^ (((ob >> 9) & 1) << 5)); }
__host__ __device__ __forceinline__ void stage_rc(int b, int& R, int& C) { const int st = b / 1024, sb = b % 1024, swz = sb ^ (((sb >> 9) & 1) << 5); R = (st >> 1) * 16 + swz / 64; C = (st & 1) * 32 + (swz % 64) / 2; }
__host__ __device__ __forceinline__ int perm32(int rho) { const int n = rho >> 4, i = rho & 15; return 8 * (i >> 2) + 4 * n + (i & 3); }

struct Unit { int pm, pn, ex, ploc; };

__device__ __forceinline__ unsigned magic_of(unsigned d) { return (unsigned)((0x100000000ull + d - 1) / d); }
__device__ __forceinline__ int div_magic(int x, unsigned mg) { return (int)__umulhi((unsigned)x, mg); }
template <bool LIN> struct DenseOrderT {
    static constexpr bool LINEAR = LIN;
    static constexpr bool GATHER = LIN;
    int nM, nN, nwg, G, c; unsigned mg_nig;
    __device__ void init(int M, int N, int G_, int c_) { nM = M / BM; nN = N / BM; nwg = nM * nN; G = G_; c = c_; mg_nig = __builtin_amdgcn_readfirstlane(magic_of((unsigned)(WGM * nN))); }
    __device__ bool next(int i, Unit& u) const {
        const long L = (long)i * G + c; if (L >= nwg) return false;
        int wgid = (int)L; { const int q = nwg / NXCD, r = nwg % NXCD, xcd = wgid % NXCD, off = wgid / NXCD; wgid = (xcd < r ? xcd * (q + 1) : r * (q + 1) + (xcd - r) * q) + off; }
        const int nig = WGM * nN, gid = div_magic(wgid, mg_nig), rem = wgid - gid * nig, fm = gid * WGM, gsz = (nM - fm) < WGM ? (nM - fm) : WGM;
        int pn;
        if (gsz == WGM) pn = rem / WGM;
        else { const unsigned mg = gsz == 1 ? 65536u : gsz == 2 ? 32768u : gsz == 3 ? 21846u : gsz == 4 ? 16384u : gsz == 5 ? 13108u : gsz == 6 ? 10923u : 9363u; pn = (int)(((unsigned)rem * mg) >> 16); }
        u.pm = fm + (rem - pn * gsz); u.pn = pn; u.ex = 0; u.ploc = 0; return true;
    }
    __device__ __forceinline__ size_t bexp(const Unit&) const { return 0; }
    __device__ __forceinline__ int arow(const Unit& u, int r) const { return u.pm * BM + r; }
};
using DenseOrder = DenseOrderT<false>;
template <bool LIN> struct InProjL1OrderT {
    static constexpr bool GATHER = LIN, LINEAR = LIN;
    DenseOrder D; int G, c, nlat;
    __device__ void init(int G_, int c_) { D.init(ML, NPR, G_, 0); G = G_; c = c_; nlat = (ML / BM) * (NPR / BM); }
    __device__ bool next(int i, Unit& u) const {
        const int L = i * G + c;
        if (L < nlat) { DenseOrder T = D; T.c = c; return T.next(i, u); }
        const int q = L - nlat; if (q >= (MC / BM) * 5) return false;
        const int t = q % 5; u.pm = ML / BM + q / 5; u.pn = (t == 0) ? 5 : (t == 1) ? 6 : 5 + t + 1; u.ex = 0; u.ploc = 0; return true;
    }
    __device__ __forceinline__ size_t bexp(const Unit&) const { return 0; }
    __device__ __forceinline__ int arow(const Unit& u, int r) const { return u.pm * BM + r; }
};
using InProjL1Order = InProjL1OrderT<false>;
template <bool GATHER_, bool LINEAR_ = false> struct MoeOrder {
    static constexpr bool GATHER = GATHER_ || LINEAR_, LINEAR = LINEAR_;
    const int* rowtok;
    size_t bstride;
    int nN, G, c, npan; int pf[7]; unsigned mg_nN;
    __device__ void init(const unsigned* cnt_, const int* rowtok_, size_t bstride_, int N, int G_, int c_) { rowtok = rowtok_; bstride = bstride_; nN = N / BM; G = G_; c = c_;
        int acc = 0;
#pragma unroll
        for (int j = 0; j < NEXP; ++j) { const int cj = __builtin_amdgcn_readfirstlane((int)cnt_[j * 64]); acc += (cj + BM - 1) / BM; if (j < 7) pf[j] = acc; }
        npan = acc;
        mg_nN = __builtin_amdgcn_readfirstlane(magic_of((unsigned)nN)); }
    __device__ bool next(int i, Unit& u) const {
        const long L = (long)i * G + c; const int U = npan * nN; if (L >= U) return false;
        int wgid = (int)L; { const int q = U / NXCD, r = U % NXCD, xcd = wgid % NXCD, off = wgid / NXCD; wgid = (xcd < r ? xcd * (q + 1) : r * (q + 1) + (xcd - r) * q) + off; }
        u.pm = div_magic(wgid, mg_nN); u.pn = wgid - u.pm * nN;
        int e = 0, pb = 0;
#pragma unroll
        for (int j = 0; j < 7; ++j) if (u.pm >= pf[j]) { e = j + 1; pb = pf[j]; }
        u.ex = e; u.ploc = u.pm - pb; return true;
    }
    __device__ __forceinline__ size_t bexp(const Unit& u) const { return (size_t)u.ex * bstride; }
    __device__ __forceinline__ int arow(const Unit& u, int r) const { if (LINEAR_) return u.pm * BM + r; const int ts = rowtok[u.ex * 65536 + u.ploc * BM + r]; return ts < 0 ? 0 : (ts >> 1); }
};

template <class Epi, class Sched, int QM = 0>
__device__ __forceinline__ void gemm_phase(LAS unsigned char* lds, const int wv, const bf16* Aptr, const bf16* Btptr, const int K, const Sched& S, const Epi& E) {
    constexpr bool GATHER = Sched::GATHER, LINEAR = Sched::LINEAR; constexpr bool F8 = (QM == 1), I8 = (QM == 2);
    const int lane = lane_id_fresh(), wid = wv, tid = wid * 64 + lane, wr = wid >> 2, wc = wid & 3, fr = lane & 15, fq = lane >> 4;
    const int nt = K / BK;
    unsigned voffA[2], voffB[2];
#pragma unroll
    for (int i = 0; i < 2; ++i) { int R, C; stage_rc(tid * 16 + i * 8192, R, C); const int Rb = Epi::PERM ? ((R & ~31) + perm32(R & 31)) : R;
        voffA[i] = (unsigned)(R * K + C) * 2u; voffB[i] = (unsigned)(Rb * K + C) * 2u; }
    const size_t kstep = (size_t)(BK * 2);
    const size_t hstep = (size_t)HALF * K * 2;
    const size_t tstep = 2 * hstep;
    const unsigned ldsw = (unsigned)wid * 1024u;
    const int aoff = lds_byte(wr * 64 + fr, fq * 8), boff = lds_byte(wc * 32 + fr, fq * 8);
#define PG8_SA(b, h) (((b) * 2 + (h)) * HTB)
#define PG8_SB(b, h) ((4 + (b) * 2 + (h)) * HTB)
#define PG8_STAGE(bufoff, gbase, voff) do { _Pragma("unroll") for (int _i = 0; _i < 2; ++_i) \
        __builtin_amdgcn_global_load_lds((const unsigned*)((const char*)(gbase) + (voff)[_i]), (LAS unsigned*)(lds + (bufoff) + ldsw + _i * 8192), 16, 0, 0); } while (0)
#define PG8_LDA(dst, b, h) do { if constexpr (F8) { _Pragma("unroll") for (int m = 0; m < 4; ++m) dst##8[m] = __builtin_shufflevector(*(const LAS i32x4*)(lds + PG8_SA(b, h) + aoff + m * 2048), *(const LAS i32x4*)(lds + PG8_SA(b, h) + aoff + m * 2048 + 1024), 0, 1, 2, 3, 4, 5, 6, 7); } \
        else { _Pragma("unroll") for (int m = 0; m < 4; ++m) _Pragma("unroll") for (int k = 0; k < 2; ++k) dst[m][k] = *(const LAS bf16x8*)(lds + PG8_SA(b, h) + aoff + m * 2048 + k * 1024); } } while (0)
#define PG8_LDB(dst, b, h) do { if constexpr (F8) { _Pragma("unroll") for (int n = 0; n < 2; ++n) dst##8[n] = __builtin_shufflevector(*(const LAS i32x4*)(lds + PG8_SB(b, h) + boff + n * 2048), *(const LAS i32x4*)(lds + PG8_SB(b, h) + boff + n * 2048 + 1024), 0, 1, 2, 3, 4, 5, 6, 7); } \
        else { _Pragma("unroll") for (int n = 0; n < 2; ++n) _Pragma("unroll") for (int k = 0; k < 2; ++k) dst[n][k] = *(const LAS bf16x8*)(lds + PG8_SB(b, h) + boff + n * 2048 + k * 1024); } } while (0)
#define PG8_MMA(ai, bj, At, Bt) do { __builtin_amdgcn_s_setprio(1); \
        if constexpr (F8) { _Pragma("unroll") for (int m = 0; m < 4; ++m) _Pragma("unroll") for (int n = 0; n < 2; ++n) \
            acc[ai][bj][m][n] = __builtin_amdgcn_mfma_scale_f32_16x16x128_f8f6f4(Bt##8[n], At##8[m], acc[ai][bj][m][n], 0, 0, 0, 0x7F7F7F7F, 0, 0x7F7F7F7F); } \
        else if constexpr (I8) { _Pragma("unroll") for (int m = 0; m < 4; ++m) _Pragma("unroll") for (int n = 0; n < 2; ++n) _Pragma("unroll") for (int k = 0; k < 2; ++k) \
            acc[ai][bj][m][n] = __builtin_bit_cast(f32x4, __builtin_amdgcn_mfma_i32_16x16x64_i8(__builtin_bit_cast(i32x4, Bt[n][k]), __builtin_bit_cast(i32x4, At[m][k]), __builtin_bit_cast(i32x4, acc[ai][bj][m][n]), 0, 0, 0)); } \
        else { _Pragma("unroll") for (int m = 0; m < 4; ++m) _Pragma("unroll") for (int n = 0; n < 2; ++n) _Pragma("unroll") for (int k = 0; k < 2; ++k) \
            acc[ai][bj][m][n] = __builtin_amdgcn_mfma_f32_16x16x32_bf16(Bt[n][k], At[m][k], acc[ai][bj][m][n], 0, 0, 0); } \
        __builtin_amdgcn_s_setprio(0); } while (0)
#define PG8_WAIT_V(n) asm volatile("s_waitcnt vmcnt(" #n ")" ::: "memory")
#define PG8_WAIT_L(n) asm volatile("s_waitcnt lgkmcnt(" #n ")" ::: "memory")
#define PG8_BAR __builtin_amdgcn_s_barrier()
#define PG8_SCHED __builtin_amdgcn_sched_barrier(0)
    Unit cur, nxt; int ui = 0;
    if (!S.next(0, cur)) return;
    f32x4 acc[2][2][4][2];
#pragma unroll
    for (int a = 0; a < 2; ++a)
#pragma unroll
        for (int b = 0; b < 2; ++b)
#pragma unroll
            for (int m = 0; m < 4; ++m)
#pragma unroll
                for (int n = 0; n < 2; ++n) acc[a][b][m][n] = (f32x4){0.f, 0.f, 0.f, 0.f};
    bf16x8 At[4][2], B0[2][2], B1[2][2];
    i32x8 At8[4], B08[2], B18[2];
    unsigned gAc0[2], gAc1[2];
    LAS u32x4* gslot = (LAS u32x4*)(lds + STAGE_BYTES) + tid;
    if constexpr (GATHER) {
#pragma unroll
        for (int i = 0; i < 2; ++i) { int R, C; stage_rc(tid * 16 + i * 8192, R, C); gAc0[i] = (unsigned)(S.arow(cur, R) * K + C) * 2u; gAc1[i] = (unsigned)(S.arow(cur, HALF + R) * K + C) * 2u; }
    }
    const char* cA = GATHER ? (const char*)Aptr : (const char*)Aptr + (size_t)cur.pm * tstep;
    const char* cB = (const char*)Btptr + S.bexp(cur) + (size_t)cur.pn * tstep;
#define PG8_STAGE_A(bufoff, kbase, half, usenext) do { if constexpr (GATHER) { if (half) PG8_STAGE(bufoff, kbase, gAc1); else PG8_STAGE(bufoff, kbase, gAc0); } \
        else { PG8_STAGE(bufoff, (kbase) + ((half) ? hstep : 0), voffA); } } while (0)
    PG8_STAGE(PG8_SB(0, 0), cB, voffB); PG8_STAGE(PG8_SB(0, 1), cB + hstep, voffB); PG8_STAGE_A(PG8_SA(0, 0), cA, 0, false); PG8_STAGE_A(PG8_SA(0, 1), cA, 1, false);
    if (wr == 1) PG8_BAR;
    PG8_WAIT_V(2); PG8_BAR;
    PG8_STAGE(PG8_SB(1, 0), cB + kstep, voffB); PG8_STAGE_A(PG8_SA(1, 0), cA + kstep, 0, false); PG8_STAGE(PG8_SB(1, 1), cB + hstep + kstep, voffB);
    PG8_WAIT_V(6); PG8_BAR;
    for (;;) {
        const bool has_next = S.next(ui + 1, nxt);
        const char* nA = GATHER ? (const char*)Aptr : (has_next ? (const char*)Aptr + (size_t)nxt.pm * tstep : cA);
        const char* nB = has_next ? (const char*)Btptr + S.bexp(nxt) + (size_t)nxt.pn * tstep : cB;
        const unsigned lin_dlt = (LINEAR && has_next) ? (unsigned)((nxt.pm - cur.pm) * (int)tstep) : 0u;
        if constexpr (GATHER && !LINEAR) {
            u32x4 gn;
            if (has_next) { int R, C; stage_rc(tid * 16, R, C); gn.x = (unsigned)(S.arow(nxt, R) * K + C) * 2u; gn.z = (unsigned)(S.arow(nxt, HALF + R) * K + C) * 2u;
                stage_rc(tid * 16 + 8192, R, C); gn.y = (unsigned)(S.arow(nxt, R) * K + C) * 2u; gn.w = (unsigned)(S.arow(nxt, HALF + R) * K + C) * 2u; }
            else { gn.x = gAc0[0]; gn.y = gAc0[1]; gn.z = gAc1[0]; gn.w = gAc1[1]; }
            asm volatile("ds_write_b128 %0, %1" :: "v"((unsigned)(size_t)gslot), "v"(gn) : "memory");
        }
#pragma nounroll
        for (int t = 0; t < nt; t += 2) {
            const bool last = (t == nt - 2);
            const char* a1 = cA + (size_t)(t + 1) * kstep;
            const char* a2 = last ? nA : cA + (size_t)(t + 2) * kstep; const char* b2 = last ? nB : cB + (size_t)(t + 2) * kstep;
            const char* a3 = a2 + kstep; const char* b3 = b2 + kstep;
            PG8_LDB(B0, 0, 0); PG8_LDB(B1, 0, 1); PG8_SCHED; PG8_LDA(At, 0, 0); PG8_STAGE_A(PG8_SA(1, 1), a1, 1, false);
            if constexpr (GATHER) { if (last) {
                if constexpr (LINEAR) { gAc0[0] += lin_dlt; gAc0[1] += lin_dlt; gAc1[0] += lin_dlt; gAc1[1] += lin_dlt; }
                else { u32x4 gn; asm volatile("ds_read_b128 %0, %1\n\ts_waitcnt lgkmcnt(0)" : "=v"(gn) : "v"((unsigned)(size_t)gslot) : "memory"); gAc0[0] = gn.x; gAc0[1] = gn.y; gAc1[0] = gn.z; gAc1[1] = gn.w; } } }
            PG8_WAIT_V(8); PG8_WAIT_L(0); PG8_BAR; PG8_MMA(0, 0, At, B0); PG8_MMA(0, 1, At, B1); PG8_BAR; PG8_SCHED;
            PG8_LDA(At, 0, 1); PG8_STAGE(PG8_SB(0, 0), b2, voffB); PG8_STAGE(PG8_SB(0, 1), b2 + hstep, voffB); PG8_STAGE_A(PG8_SA(0, 0), a2, 0, last);
            PG8_WAIT_V(8); PG8_WAIT_L(0); PG8_BAR; PG8_MMA(1, 0, At, B0); PG8_MMA(1, 1, At, B1); PG8_BAR; PG8_SCHED;
            PG8_LDB(B0, 1, 0); PG8_LDB(B1, 1, 1); PG8_SCHED; PG8_LDA(At, 1, 0); PG8_STAGE_A(PG8_SA(0, 1), a2, 1, last);
            PG8_WAIT_V(8); PG8_WAIT_L(0); PG8_BAR; PG8_MMA(0, 0, At, B0); PG8_MMA(0, 1, At, B1); PG8_BAR; PG8_SCHED;
            PG8_LDA(At, 1, 1); PG8_STAGE(PG8_SB(1, 0), b3, voffB); PG8_STAGE(PG8_SB(1, 1), b3 + hstep, voffB); PG8_STAGE_A(PG8_SA(1, 0), a3, 0, last);
            PG8_WAIT_V(8); PG8_WAIT_L(0); PG8_BAR; PG8_MMA(1, 0, At, B0); PG8_MMA(1, 1, At, B1); PG8_BAR; PG8_SCHED;
        }
        if (wr == 0) PG8_BAR;
        if constexpr (I8) { const int ln_ = lane_id_fresh(); E(acc, cur, wr, wc, ln_ & 15, ln_ >> 4); }
        else E(acc, cur, wr, wc, fr, fq);
        if (!has_next) break;
#pragma unroll
        for (int a = 0; a < 2; ++a)
#pragma unroll
            for (int b = 0; b < 2; ++b)
#pragma unroll
                for (int m = 0; m < 4; ++m)
#pragma unroll
                    for (int n = 0; n < 2; ++n) acc[a][b][m][n] = (f32x4){0.f, 0.f, 0.f, 0.f};
        cur = nxt; cA = nA; cB = nB; ++ui;
        if (wr == 1) PG8_BAR;
    }
    PG8_WAIT_V(0);
    PG8_BAR;
#undef PG8_SA
#undef PG8_SB
#undef PG8_STAGE
#undef PG8_STAGE_A
#undef PG8_LDA
#undef PG8_LDB
#undef PG8_MMA
#undef PG8_WAIT_V
#undef PG8_WAIT_L
#undef PG8_BAR
#undef PG8_SCHED
}

struct EpiBf16Plain {
    static constexpr bool PERM = true;
    bf16* O; int ldc;
    __device__ __forceinline__ void operator()(const f32x4 (&acc)[2][2][4][2], const Unit& u, int wr, int wc, int fr, int fq) const {
        const int row0 = u.pm * BM + wr * 64 + fr, col0 = u.pn * BM + wc * 32 + 8 * fq;
#pragma unroll
        for (int ai = 0; ai < 2; ++ai)
#pragma unroll
            for (int m = 0; m < 4; ++m) { bf16* rowp = O + (size_t)(row0 + ai * HALF + m * 16) * ldc + col0;
#pragma unroll
                for (int bj = 0; bj < 2; ++bj) { const f32x4 v0 = acc[ai][bj][m][0], v1 = acc[ai][bj][m][1];
                    u32x4 w; w.x = pack2(v0[0], v0[1]); w.y = pack2(v0[2], v0[3]); w.z = pack2(v1[0], v1[1]); w.w = pack2(v1[2], v1[3]);
                    *(u32x4*)(rowp + bj * HALF) = w; } }
    }
};
template <bool SRC_F32> struct EpiResid {
    static constexpr bool PERM = true;
    bf16* XR; const float* xlat; const float* xctx; const float* gate;
    __device__ __forceinline__ void operator()(const f32x4 (&acc)[2][2][4][2], const Unit& u, int wr, int wc, int fr, int fq) const {
        const int m0 = u.pm * BM, row0 = m0 + wr * 64 + fr, col0 = u.pn * BM + wc * 32 + 8 * fq;
        const float* gp = gate + (size_t)(m0 < ML ? (m0 >> 11) : 32) * 6144 + col0;
        f32x4 g[2][2];
        bf16* xr = XR + (size_t)row0 * DM + col0;
#define EPR_GATE _Pragma("unroll") for (int bj = 0; bj < 2; ++bj) _Pragma("unroll") for (int n = 0; n < 2; ++n) g[bj][n] = *(const f32x4*)(gp + bj * HALF + 4 * n);
        if constexpr (!SRC_F32) {
            u32x4 sv[2][4][2];
#pragma unroll
            for (int ai = 0; ai < 2; ++ai)
#pragma unroll
                for (int m = 0; m < 4; ++m)
#pragma unroll
                    for (int bj = 0; bj < 2; ++bj) sv[ai][m][bj] = *(const u32x4*)(xr + (size_t)(ai * HALF + m * 16) * DM + bj * HALF);
            EPR_GATE
            __builtin_amdgcn_sched_barrier(0);
#pragma unroll
            for (int ai = 0; ai < 2; ++ai)
#pragma unroll
                for (int m = 0; m < 4; ++m)
#pragma unroll
                    for (int bj = 0; bj < 2; ++bj) { const u32x4 x = sv[ai][m][bj]; const f32x4 v0 = acc[ai][bj][m][0] * g[bj][0], v1 = acc[ai][bj][m][1] * g[bj][1];
                        u32x4 w; w.x = pack2(bflo(x.x) + v0[0], bfhi(x.x) + v0[1]); w.y = pack2(bflo(x.y) + v0[2], bfhi(x.y) + v0[3]); w.z = pack2(bflo(x.z) + v1[0], bfhi(x.z) + v1[1]); w.w = pack2(bflo(x.w) + v1[2], bfhi(x.w) + v1[3]);
                        *(u32x4*)(xr + (size_t)(ai * HALF + m * 16) * DM + bj * HALF) = w; }
        } else {
            const float* sp = (m0 < ML ? xlat + (size_t)row0 * DM : xctx + (size_t)(row0 - ML) * DM) + col0;
#pragma unroll
            for (int ai = 0; ai < 2; ++ai) {
                f32x4 sf[4][2][2];
#pragma unroll
                for (int m = 0; m < 4; ++m)
#pragma unroll
                    for (int bj = 0; bj < 2; ++bj)
#pragma unroll
                        for (int n = 0; n < 2; ++n) sf[m][bj][n] = *(const f32x4*)(sp + (size_t)(ai * HALF + m * 16) * DM + bj * HALF + 4 * n);
                if (ai == 0) { EPR_GATE }
                __builtin_amdgcn_sched_barrier(0);
#pragma unroll
                for (int m = 0; m < 4; ++m)
#pragma unroll
                    for (int bj = 0; bj < 2; ++bj) { const f32x4 v0 = sf[m][bj][0] + acc[ai][bj][m][0] * g[bj][0], v1 = sf[m][bj][1] + acc[ai][bj][m][1] * g[bj][1];
                        u32x4 w; w.x = pack2(v0[0], v0[1]); w.y = pack2(v0[2], v0[3]); w.z = pack2(v1[0], v1[1]); w.w = pack2(v1[2], v1[3]);
                        *(u32x4*)(xr + (size_t)(ai * HALF + m * 16) * DM + bj * HALF) = w; }
                __builtin_amdgcn_sched_barrier(0);
            }
        }
#undef EPR_GATE
    }
};
struct EpiInProj {
    static constexpr bool PERM = true;
    bf16* O; bf16* VT;
    __device__ __forceinline__ void operator()(const f32x4 (&acc)[2][2][4][2], const Unit& u, int wr, int wc, int fr, int fq) const {
        if (u.pn == 6) {
            const int m0 = u.pm * BM; int b, tb;
            if (m0 < ML) { b = m0 >> 11; tb = 256 + (m0 - (b << 11)); } else { b = (m0 - ML) >> 8; tb = 0; }
            bf16* vb = VT + (size_t)b * 256 * VT_LD + tb + wr * 64 + fr;
            const int c0 = wc * 32 + 8 * fq;
#pragma unroll
            for (int ai = 0; ai < 2; ++ai)
#pragma unroll
                for (int m = 0; m < 4; ++m)
#pragma unroll
                    for (int bj = 0; bj < 2; ++bj)
#pragma unroll
                        for (int n = 0; n < 2; ++n)
#pragma unroll
                            for (int e = 0; e < 4; ++e) vb[(size_t)(c0 + bj * HALF + 4 * n + e) * VT_LD + ai * HALF + m * 16] = f2bf(acc[ai][bj][m][n][e]);
            return;
        }
        const int row0 = u.pm * BM + wr * 64 + fr, col0 = u.pn * BM + wc * 32 + 8 * fq;
#pragma unroll
        for (int ai = 0; ai < 2; ++ai)
#pragma unroll
            for (int m = 0; m < 4; ++m) { bf16* rowp = O + (size_t)(row0 + ai * HALF + m * 16) * NPR + col0;
#pragma unroll
                for (int bj = 0; bj < 2; ++bj) { const f32x4 v0 = acc[ai][bj][m][0], v1 = acc[ai][bj][m][1];
                    u32x4 w; w.x = pack2(v0[0], v0[1]); w.y = pack2(v0[2], v0[3]); w.z = pack2(v1[0], v1[1]); w.w = pack2(v1[2], v1[3]);
                    *(u32x4*)(rowp + bj * HALF) = w; } }
    }
};
struct EpiInProjI8 {
    static constexpr bool PERM = true;
    bf16* O; bf16* VT; const float* rs; const float* cs;
    __device__ __forceinline__ void operator()(const f32x4 (&acc)[2][2][4][2], const Unit& u, int wr, int wc, int fr, int fq) const {
        const int row0 = u.pm * BM + wr * 64 + fr, col0 = u.pn * BM + wc * 32 + 8 * fq;
        f32x4 cv[2][2];
#pragma unroll
        for (int bj = 0; bj < 2; ++bj)
#pragma unroll
            for (int n = 0; n < 2; ++n) cv[bj][n] = *(const f32x4*)(cs + col0 + bj * HALF + 4 * n);
        if (u.pn == 6) {
            const int m0 = u.pm * BM; int b, tb;
            if (m0 < ML) { b = m0 >> 11; tb = 256 + (m0 - (b << 11)); } else { b = (m0 - ML) >> 8; tb = 0; }
            bf16* vb = VT + (size_t)b * 256 * VT_LD + tb + wr * 64 + fr;
            const int c0 = wc * 32 + 8 * fq;
#pragma unroll
            for (int ai = 0; ai < 2; ++ai)
#pragma unroll
                for (int m = 0; m < 4; ++m) { const float rsv = rs[row0 + ai * HALF + m * 16];
#pragma unroll
                    for (int bj = 0; bj < 2; ++bj)
#pragma unroll
                        for (int n = 0; n < 2; ++n)
#pragma unroll
                            for (int e = 0; e < 4; ++e) vb[(size_t)(c0 + bj * HALF + 4 * n + e) * VT_LD + ai * HALF + m * 16] = f2bf((float)__float_as_int(acc[ai][bj][m][n][e]) * (rsv * cv[bj][n][e])); }
            return;
        }
        float rsa[2][4];
#pragma unroll
        for (int ai = 0; ai < 2; ++ai)
#pragma unroll
            for (int m = 0; m < 4; ++m) rsa[ai][m] = rs[row0 + ai * HALF + m * 16];
        __builtin_amdgcn_sched_barrier(0);
#pragma unroll
        for (int ai = 0; ai < 2; ++ai)
#pragma unroll
            for (int m = 0; m < 4; ++m) { const int row = row0 + ai * HALF + m * 16; const float rsv = rsa[ai][m]; bf16* rowp = O + (size_t)row * NPR + col0;
#pragma unroll
                for (int bj = 0; bj < 2; ++bj) { float v[8];
#pragma unroll
                    for (int n = 0; n < 2; ++n)
#pragma unroll
                        for (int e = 0; e < 4; ++e) v[n * 4 + e] = (float)__float_as_int(acc[ai][bj][m][n][e]) * (rsv * cv[bj][n][e]);
                    u32x4 w; w.x = pack2(v[0], v[1]); w.y = pack2(v[2], v[3]); w.z = pack2(v[4], v[5]); w.w = pack2(v[6], v[7]);
                    *(u32x4*)(rowp + bj * HALF) = w; } }
    }
};
struct EpiSwiglu {
    static constexpr bool PERM = true;
    bf16* Hd; int ldc;
    __device__ __forceinline__ void operator()(const f32x4 (&acc)[2][2][4][2], const Unit& u, int wr, int wc, int fr, int fq) const {
        const int row0 = u.pm * BM + wr * 64 + fr, col0 = u.pn * HALF + wc * 32 + 8 * fq;
#pragma unroll
        for (int ai = 0; ai < 2; ++ai)
#pragma unroll
            for (int m = 0; m < 4; ++m) { bf16* rowp = Hd + (size_t)(row0 + ai * HALF + m * 16) * ldc + col0;
                float h[8];
#pragma unroll
                for (int n = 0; n < 2; ++n)
#pragma unroll
                    for (int j = 0; j < 4; ++j) { const float g = acc[ai][0][m][n][j], uu = acc[ai][1][m][n][j]; h[n * 4 + j] = g * __builtin_amdgcn_rcpf(1.0f + __expf(-g)) * uu; }
                u32x4 w; w.x = pack2(h[0], h[1]); w.y = pack2(h[2], h[3]); w.z = pack2(h[4], h[5]); w.w = pack2(h[6], h[7]);
                *(u32x4*)rowp = w; }
    }
};
struct EpiSwigluI8 {
    static constexpr bool PERM = true;
    bf16* Hd; int ldc; const float* rs; const float* cs; int F;
    __device__ __forceinline__ void operator()(const f32x4 (&acc)[2][2][4][2], const Unit& u, int wr, int wc, int fr, int fq) const {
        const int row0 = u.pm * BM + wr * 64 + fr, col0 = u.pn * HALF + wc * 32 + 8 * fq;
        const f32x4 cg0 = *(const f32x4*)(cs + col0), cg1 = *(const f32x4*)(cs + col0 + 4), cu0 = *(const f32x4*)(cs + F + col0), cu1 = *(const f32x4*)(cs + F + col0 + 4);
        float rsa[2][4];
#pragma unroll
        for (int ai = 0; ai < 2; ++ai)
#pragma unroll
            for (int m = 0; m < 4; ++m) rsa[ai][m] = rs[row0 + ai * HALF + m * 16];
        __builtin_amdgcn_sched_barrier(0);
#pragma unroll
        for (int ai = 0; ai < 2; ++ai)
#pragma unroll
            for (int m = 0; m < 4; ++m) { const int row = row0 + ai * HALF + m * 16; const float rsv = rsa[ai][m]; bf16* rowp = Hd + (size_t)row * ldc + col0;
                float h[8];
#pragma unroll
                for (int n = 0; n < 2; ++n)
#pragma unroll
                    for (int j = 0; j < 4; ++j) { const float g = (float)__float_as_int(acc[ai][0][m][n][j]) * (rsv * (n ? cg1[j] : cg0[j])), uu = (float)__float_as_int(acc[ai][1][m][n][j]) * (rsv * (n ? cu1[j] : cu0[j]));
                        h[n * 4 + j] = g * __builtin_amdgcn_rcpf(1.0f + __expf(-g)) * uu; }
                u32x4 w; w.x = pack2(h[0], h[1]); w.y = pack2(h[2], h[3]); w.z = pack2(h[4], h[5]); w.w = pack2(h[6], h[7]);
                *(u32x4*)rowp = w; }
    }
};
struct EpiSwigluF8 {
    static constexpr bool PERM = true;
    unsigned char* Hd;
    __device__ __forceinline__ void operator()(const f32x4 (&acc)[2][2][4][2], const Unit& u, int wr, int wc, int fr, int fq) const {
        const int row0 = u.pm * BM + wr * 64 + fr, col0 = u.pn * HALF + wc * 32 + 8 * fq;
#pragma unroll
        for (int ai = 0; ai < 2; ++ai)
#pragma unroll
            for (int m = 0; m < 4; ++m) { unsigned char* rowp = Hd + (size_t)(row0 + ai * HALF + m * 16) * DFEP + col0;
                float h[8];
#pragma unroll
                for (int n = 0; n < 2; ++n)
#pragma unroll
                    for (int j = 0; j < 4; ++j) { const float g = acc[ai][0][m][n][j] * (1.0f / W8S), uu = acc[ai][1][m][n][j] * (H8S / W8S); h[n * 4 + j] = g * __builtin_amdgcn_rcpf(1.0f + __expf(-g)) * uu; }
                u32x2 w; w.x = pack4_fp8(h[0], h[1], h[2], h[3]); w.y = pack4_fp8(h[4], h[5], h[6], h[7]);
                *(u32x2*)rowp = w;
                if (u.pn == DFE / HALF - 1) *(u32x2*)(rowp + HALF) = (u32x2){0u, 0u}; }
    }
};
struct EpiMoeOut {
    static constexpr bool PERM = true;
    bf16* Y; const int* rowtok; const float* gates;
    __device__ __forceinline__ void operator()(const f32x4 (&acc)[2][2][4][2], const Unit& u, int wr, int wc, int fr, int fq) const {
        const int prow0 = u.ploc * BM + wr * 64 + fr, col0 = u.pn * BM + wc * 32 + 8 * fq;
        int ts[2][4]; float gt[2][4];
#pragma unroll
        for (int ai = 0; ai < 2; ++ai)
#pragma unroll
            for (int m = 0; m < 4; ++m) ts[ai][m] = rowtok[u.ex * 65536 + prow0 + ai * HALF + m * 16];
#pragma unroll
        for (int ai = 0; ai < 2; ++ai)
#pragma unroll
            for (int m = 0; m < 4; ++m) gt[ai][m] = gates[max(ts[ai][m], 0)] * (1.0f / (W8S * H8S));
        __builtin_amdgcn_sched_barrier(0);
#pragma unroll
        for (int ai = 0; ai < 2; ++ai)
#pragma unroll
            for (int m = 0; m < 4; ++m) {
                if (ts[ai][m] >= 0) { const float g = gt[ai][m]; bf16* rowp = Y + (size_t)ts[ai][m] * DM + col0;
#pragma unroll
                    for (int bj = 0; bj < 2; ++bj) { const f32x4 v0 = acc[ai][bj][m][0] * g, v1 = acc[ai][bj][m][1] * g;
                        u32x4 w; w.x = pack2(v0[0], v0[1]); w.y = pack2(v0[2], v0[3]); w.z = pack2(v1[0], v1[1]); w.w = pack2(v1[2], v1[3]);
                        *(u32x4*)(rowp + bj * HALF) = w; } } }
    }
};
}

struct Args { const float* in[26]; float* out; unsigned char* ws; int ph_lo, ph_hi; };
struct Frame {
    LAS unsigned char* lds; int G, bid, wv;
    float* out; unsigned char* ws;
};
__device__ __forceinline__ const float* inptr(const Frame& F, int i) {
    const LAS unsigned* t = (const LAS unsigned*)(F.lds + LDSCTL_OFF + 16) + 2 * i;
    const unsigned lo = __builtin_amdgcn_readfirstlane(t[0]), hi = __builtin_amdgcn_readfirstlane(t[1]);
    const GAS float* gp = (const GAS float*)(((unsigned long long)hi << 32) | lo);
    return (const float*)gp;
}
enum { I_X = 0, I_C, I_CTX, I_CCTX, I_WADA, I_BADA, I_GMIX, I_GFFN, I_WIN, I_WOUT, I_POOLW, I_POOLS, I_CONVW, I_RPB, I_SCW, I_SCB, I_SDTB, I_SALOG, I_SD, I_SNG, I_FGU, I_FDOWN, I_ROUTER, I_MGU, I_MDOWN, I_GFINAL };

#define PHASE_IDS const int lane = lane_id_fresh(), wave = F.wv, tid = wave * 64 + lane; (void)lane; (void)wave; (void)tid;
struct TJob { const float* src; bf16* dst; const float* cs; int ldn, k0, n0, ldk, Fm, f8; };
__device__ __forceinline__ void tconv_load(const TJob& J, int tid, f32x4& v0, f32x4& v1) {
    const int r = tid >> 4, c4 = tid & 15;
    const GAS float* p = (const GAS float*)J.src + (size_t)(J.k0 + r) * J.ldn + J.n0 + 4 * c4;
    v0 = *(const GAS f32x4*)p; v1 = *(const GAS f32x4*)(p + (size_t)32 * J.ldn);
}
__device__ __forceinline__ void tconv_lds(const f32x4& v0, const f32x4& v1, LAS float* tile, int tid) {
    const int r = tid >> 4, c4 = tid & 15;
    { LAS float* t = tile + r * 65 + 4 * c4; t[0] = v0[0]; t[1] = v0[1]; t[2] = v0[2]; t[3] = v0[3]; }
    { LAS float* t = tile + (r + 32) * 65 + 4 * c4; t[0] = v1[0]; t[1] = v1[1]; t[2] = v1[2]; t[3] = v1[3]; }
}
__device__ __forceinline__ void tconv_emit(const TJob& J, const LAS float* tile, int tid) {
    const int n = tid >> 3, ks = tid & 7;
    float f[8];
#pragma unroll
    for (int i = 0; i < 8; ++i) f[i] = tile[(ks * 8 + i) * 65 + n];
    const int nn = J.n0 + n; int drow = nn;
    if (J.Fm) { const int isu = nn >= J.Fm; const int j = isu ? nn - J.Fm : nn; drow = (j >> 7) * 256 + (isu ? 128 : 0) + (j & 127); }
    if (J.f8 == 2) { const float inv = 1.0f / J.cs[nn]; u32x2 w8; w8.x = pack4_i8(f[0] * inv, f[1] * inv, f[2] * inv, f[3] * inv); w8.y = pack4_i8(f[4] * inv, f[5] * inv, f[6] * inv, f[7] * inv);
        *(u32x2*)((unsigned char*)J.dst + (size_t)drow * J.ldk + J.k0 + ks * 8) = w8; }
    else if (J.f8) { u32x2 w8; w8.x = pack4_fp8(f[0] * W8S, f[1] * W8S, f[2] * W8S, f[3] * W8S); w8.y = pack4_fp8(f[4] * W8S, f[5] * W8S, f[6] * W8S, f[7] * W8S);
        *(u32x2*)((unsigned char*)J.dst + (size_t)drow * J.ldk + J.k0 + ks * 8) = w8; }
    else { u32x4 w; w.x = pack2(f[0], f[1]); w.y = pack2(f[2], f[3]); w.z = pack2(f[4], f[5]); w.w = pack2(f[6], f[7]);
        *(u32x4*)(J.dst + (size_t)drow * J.ldk + J.k0 + ks * 8) = w; }
}
__device__ __forceinline__ TJob tdecode(const Frame& F, int T) {
    unsigned char* wb = F.ws + WS_WB;
    TJob J; J.Fm = 0; J.f8 = 0; J.cs = nullptr;
    if (T < 1408) { const int l = T / 704, t = T % 704; J.src = inptr(F, I_WIN) + (size_t)l * DM * DIN; J.ldn = DIN; J.k0 = (t / 44) * 64; J.n0 = (t % 44) * 64; J.dst = (bf16*)(wb + WB_IN + l * WB_IN_SZ); J.ldk = DM;
        J.f8 = 2; J.cs = (const float*)(F.ws + WS_CSIN) + l * NPR; }
    else if (T < 1920) { const int q = T - 1408, l = q / 256, t = q % 256; J.src = inptr(F, I_WOUT) + (size_t)l * DM * DM; J.ldn = DM; J.k0 = (t / 16) * 64; J.n0 = (t % 16) * 64; J.dst = (bf16*)(wb + WB_OUT + l * WB_OUT_SZ); J.ldk = DM; }
    else if (T < 3328) { const int t = T - 1920; J.src = inptr(F, I_FGU); J.ldn = 2 * DFF; J.k0 = (t / 88) * 64; J.n0 = (t % 88) * 64; J.dst = (bf16*)(wb + WB_GU); J.ldk = DM; J.Fm = DFF; J.f8 = 2; J.cs = (const float*)(F.ws + WS_CS); }
    else if (T < 4032) { const int t = T - 3328; J.src = inptr(F, I_FDOWN); J.ldn = DM; J.k0 = (t / 16) * 64; J.n0 = (t % 16) * 64; J.dst = (bf16*)(wb + WB_DOWN); J.ldk = DFF; }
    else if (T < 9664) { const int q = T - 4032, e = q / 704, t = q % 704; J.src = inptr(F, I_MGU) + (size_t)e * DM * 2 * DFE; J.ldn = 2 * DFE; J.k0 = (t / 44) * 64; J.n0 = (t % 44) * 64; J.dst = (bf16*)(wb + WB_MGU + e * WB_MGU_SZ); J.ldk = DM; J.Fm = DFE; J.f8 = 1; }
    else { const int q = T - 9664, e = q / 352, t = q % 352; J.src = inptr(F, I_MDOWN) + (size_t)e * DFE * DM; J.ldn = DM; J.k0 = (t / 16) * 64; J.n0 = (t % 16) * 64; J.dst = (bf16*)(wb + WB_MDOWN + e * WB_MDOWN_SZ); J.ldk = DFEP; J.f8 = 1; }
    return J;
}
__device__ __forceinline__ void conv_tiles(const Frame& F, const int lo0, const int n0, const int lo1, const int n1, const int w, const int nw) {
    PHASE_IDS
    constexpr int NT = 4;
    LAS float* ldsf = (LAS float*)F.lds;
    const int nT = n0 + n1;
#define TV(v) ((v) < n0 ? lo0 + (v) : lo1 + ((v) - n0))
    int g = w;
    if (g * NT >= nT) return;
    f32x4 cv[NT][2], nv[NT][2];
#pragma unroll
    for (int j = 0; j < NT; ++j) { cv[j][0] = cv[j][1] = (f32x4){0.f, 0.f, 0.f, 0.f}; if (g * NT + j < nT) { const TJob J = tdecode(F, TV(g * NT + j)); tconv_load(J, tid, cv[j][0], cv[j][1]); } }
    for (; g * NT < nT; g += nw) {
        const int gn = g + nw;
#pragma unroll
        for (int j = 0; j < NT; ++j) { nv[j][0] = cv[j][0]; nv[j][1] = cv[j][1]; if (gn * NT + j < nT) { const TJob J = tdecode(F, TV(gn * NT + j)); tconv_load(J, tid, nv[j][0], nv[j][1]); } }
#pragma unroll
        for (int j = 0; j < NT; ++j) if (g * NT + j < nT) tconv_lds(cv[j][0], cv[j][1], ldsf + j * (64 * 65), tid);
        __syncthreads();
#pragma unroll
        for (int j = 0; j < NT; ++j) if (g * NT + j < nT) { const TJob J = tdecode(F, TV(g * NT + j)); tconv_emit(J, ldsf + j * (64 * 65), tid); }
        __syncthreads();
#pragma unroll
        for (int j = 0; j < NT; ++j) { cv[j][0] = nv[j][0]; cv[j][1] = nv[j][1]; }
    }
#undef TV
}
__device__ __forceinline__ bool tail_worker(const Frame& F, int nunits, int& w, int& nw) { const int r = nunits % F.G; w = F.bid - r; nw = F.G - r; return F.bid >= r; }
__device__ __forceinline__ void p0_prologue(const Frame& F) {
    PHASE_IDS
    unsigned char* wb = F.ws + WS_WB;
    LAS float* ldsf = (LAS float*)F.lds;
    if (F.bid < 192) {
        constexpr int ADA_LD = 1028;
        const int l = F.bid / 96, cg = F.bid % 96;
        { const GAS float* cl = (const GAS float*)inptr(F, I_C); const GAS float* cx = (const GAS float*)inptr(F, I_CCTX);
          f32x4 cv[17];
#pragma unroll
          for (int it = 0; it < 17; ++it) { const int i4 = tid + 512 * it, b = i4 >> 8, k4 = i4 & 255; cv[it] = (f32x4){0.f, 0.f, 0.f, 0.f};
              if (i4 < 33 * 256) cv[it] = (b < 32) ? *(const GAS f32x4*)(cl + b * 1024 + 4 * k4) : *(const GAS f32x4*)(cx + 4 * k4); }
#pragma unroll
          for (int it = 0; it < 17; ++it) { const int i4 = tid + 512 * it, b = i4 >> 8, k4 = i4 & 255;
              if (i4 < 33 * 256) { f32x4 sv; sv[0] = silu_f(cv[it][0]); sv[1] = silu_f(cv[it][1]); sv[2] = silu_f(cv[it][2]); sv[3] = silu_f(cv[it][3]); *(LAS f32x4*)(ldsf + b * ADA_LD + 4 * k4) = sv; } } }
        __syncthreads();
        const int lq = lane & 15, g = lane >> 4;
        f32x4 acc[3][4];
#pragma unroll
        for (int mt = 0; mt < 3; ++mt)
#pragma unroll
            for (int nt = 0; nt < 4; ++nt) acc[mt][nt] = (f32x4){0.f, 0.f, 0.f, 0.f};
        const GAS float* wbase = (const GAS float*)inptr(F, I_WADA) + (size_t)l * 1024 * 6144 + cg * 64 + lq + (size_t)(wave * 128 + 8 * g) * 6144;
        float wc[4][8], wn[4][8];
#define ADA_WLOAD(dst, ks) do { _Pragma("unroll") for (int nt = 0; nt < 4; ++nt) _Pragma("unroll") for (int j = 0; j < 8; ++j) dst[nt][j] = wbase[(size_t)((ks) * 32 + j) * 6144 + 16 * nt]; } while (0)
#define ADA_SPLIT(v, hi, lo) do { u32x4 h_, l_; _Pragma("unroll") for (int i = 0; i < 4; ++i) { const unsigned ph_ = pack2(v[2 * i], v[2 * i + 1]); h_[i] = ph_; l_[i] = pack2(v[2 * i] - bflo(ph_), v[2 * i + 1] - bfhi(ph_)); } \
            hi = __builtin_bit_cast(bf16x8, h_); lo = __builtin_bit_cast(bf16x8, l_); } while (0)
        ADA_WLOAD(wc, 0);
#pragma unroll
        for (int ks = 0; ks < 4; ++ks) {
            if (ks + 1 < 4) ADA_WLOAD(wn, ks + 1);
            bf16x8 ah[3], al[3];
#pragma unroll
            for (int mt = 0; mt < 3; ++mt) { const int row = min(16 * mt + lq, 32); const LAS float* ap = ldsf + row * ADA_LD + wave * 128 + ks * 32 + 8 * g;
                const f32x4 a0 = *(const LAS f32x4*)ap, a1 = *(const LAS f32x4*)(ap + 4); const float av[8] = {a0[0], a0[1], a0[2], a0[3], a1[0], a1[1], a1[2], a1[3]};
                ADA_SPLIT(av, ah[mt], al[mt]); }
#pragma unroll
            for (int nt = 0; nt < 4; ++nt) { bf16x8 wh, wl; ADA_SPLIT(wc[nt], wh, wl);
#pragma unroll
                for (int mt = 0; mt < 3; ++mt) { acc[mt][nt] = __builtin_amdgcn_mfma_f32_16x16x32_bf16(ah[mt], wh, acc[mt][nt], 0, 0, 0); acc[mt][nt] = __builtin_amdgcn_mfma_f32_16x16x32_bf16(ah[mt], wl, acc[mt][nt], 0, 0, 0);
                    acc[mt][nt] = __builtin_amdgcn_mfma_f32_16x16x32_bf16(al[mt], wh, acc[mt][nt], 0, 0, 0); } }
#pragma unroll
            for (int nt = 0; nt < 4; ++nt)
#pragma unroll
                for (int j = 0; j < 8; ++j) wc[nt][j] = wn[nt][j];
        }
#undef ADA_WLOAD
#undef ADA_SPLIT
        __syncthreads();
#pragma unroll
        for (int mt = 0; mt < 3; ++mt)
#pragma unroll
            for (int nt = 0; nt < 4; ++nt) *(LAS f32x4*)(ldsf + ((wave * 12 + mt * 4 + nt) * 64 + lane) * 4) = acc[mt][nt];
        __syncthreads();
        float* mod = (float*)(F.ws + WS_MOD) + (size_t)l * 33 * 6144;
        for (int idx = tid; idx < 33 * 64; idx += 512) { const int b = idx >> 6, n = idx & 63; const int mt = b >> 4, gg = (b & 15) >> 2, e = b & 3, nt = n >> 4, ll = gg * 16 + (n & 15); float sm = 0.f;
#pragma unroll
            for (int w = 0; w < 8; ++w) sm += ldsf[((w * 12 + mt * 4 + nt) * 64 + ll) * 4 + e];
            mod[(size_t)b * 6144 + cg * 64 + n] = sm + inptr(F, I_BADA)[l * 6144 + cg * 64 + n]; }
        __syncthreads();
    }
    for (int cgp = F.G - 1 - F.bid; cgp < 176; cgp += F.G) {
        const bool isin = cgp >= 88; const int lyr = cgp >= 132; const int n0 = (isin ? (cgp - 88) % 44 : cgp) * 64; const int ldw = isin ? DIN : 2 * DFF;
        const int c4 = tid & 15, ks = tid >> 4;
        const GAS float* wsrc = (const GAS float*)(isin ? inptr(F, I_WIN) + (size_t)lyr * DM * DIN : inptr(F, I_FGU)) + n0 + 4 * c4 + (size_t)(ks * 32) * ldw;
        f32x4 am = (f32x4){0.f, 0.f, 0.f, 0.f};
#pragma unroll
        for (int k = 0; k < 32; ++k) { const f32x4 v = *(const GAS f32x4*)(wsrc + (size_t)k * ldw); am[0] = fmaxf(am[0], fabsf(v[0])); am[1] = fmaxf(am[1], fabsf(v[1])); am[2] = fmaxf(am[2], fabsf(v[2])); am[3] = fmaxf(am[3], fabsf(v[3])); }
        __syncthreads();
        *(LAS f32x4*)(ldsf + ks * 64 + 4 * c4) = am;
        __syncthreads();
        if (tid < 64) { float m8 = 0.f;
#pragma unroll
            for (int q = 0; q < 32; ++q) m8 = fmaxf(m8, ldsf[q * 64 + tid]);
            ((float*)(F.ws + (isin ? WS_CSIN : WS_CS)))[lyr * NPR + n0 + tid] = fmaxf(m8, 1.0e-20f) * (1.0f / 127.0f); }
        __syncthreads(); }
    for (int idx = F.bid * 512 + tid; idx < NEXP * 65536 / 4; idx += F.G * 512) *(u32x4*)(F.ws + WS_LISTE + (size_t)idx * 16) = (u32x4){0xFFFFFFFFu, 0xFFFFFFFFu, 0xFFFFFFFFu, 0xFFFFFFFFu};
    for (int idx = F.bid * 512 + tid; idx < NEXP * DM * 8; idx += F.G * 512) { const int rr = idx >> 3, q = idx & 7; *(u32x4*)(wb + WB_MDOWN + (size_t)rr * DFEP + DFE + q * 16) = (u32x4){0u, 0u, 0u, 0u}; }
}

template <int L, int MODE, bool SRC_XR, bool HAS_D>
__device__ __forceinline__ void norm_phase(const Frame& F, int nrows, const bf16* Dbuf, const float* gate) {
    PHASE_IDS
    const float* mod = (const float*)(F.ws + WS_MOD) + (size_t)L * 33 * 6144;
    constexpr bool M0 = (MODE == 0 || MODE == 6);
    const int sh_off = M0 ? 0 : 3 * 1024, sc_off = sh_off + 1024;
    const float* gsrc = (M0 ? inptr(F, I_GMIX) : inptr(F, I_GFFN)) + L * DM;
    bf16* HB = (bf16*)(F.ws + WS_HB);
    float* DT = (float*)(F.ws + WS_DT);
    bf16* XR = (bf16*)(F.ws + WS_XR);
    f32x4 wx[16][2];
    if (M0 || MODE == 2) {
#pragma unroll
        for (int j = 0; j < 4; ++j)
#pragma unroll
            for (int i = 0; i < 4; ++i) { const int k = j * 256 + lane * 4 + i;
                const float* p = M0 ? inptr(F, I_WIN) + (size_t)L * DM * DIN + (size_t)k * DIN + NPR : inptr(F, I_ROUTER) + (size_t)k * NEXP;
                wx[j * 4 + i][0] = *(const f32x4*)p; wx[j * 4 + i][1] = *(const f32x4*)(p + 4); }
    }
    const int per = (nrows + F.G * 8 - 1) / (F.G * 8), mbeg = (F.bid * 8 + wave) * per, mend = min(mbeg + per, nrows);
    f32x4 ga[4], sha[4], gtv[4]; int curmod = -1; int my_i1 = -1, my_i2 = -1;
    f32x4 v[4], vn[4]; u32x2 xb[4], xbn[4], dl[4], dln[4];
    const GAS float* xlat_p = (const GAS float*)inptr(F, I_X); const GAS float* xctx_p = (const GAS float*)inptr(F, I_CTX);
#define NP_LOAD(m, V, XB, DL) do { \
        if (SRC_XR) { const GAS bf16* s_ = (const GAS bf16*)XR + (size_t)(m) * DM + lane * 4; _Pragma("unroll") for (int j = 0; j < 4; ++j) XB[j] = *(const GAS u32x2*)(s_ + j * 256); } \
        else { const GAS float* s_ = (((m) < ML) ? xlat_p + (size_t)(m) * DM : xctx_p + (size_t)((m) - ML) * DM) + lane * 4; _Pragma("unroll") for (int j = 0; j < 4; ++j) V[j] = *(const GAS f32x4*)(s_ + j * 256); } \
        if (HAS_D) { const GAS bf16* d_ = (const GAS bf16*)Dbuf + (size_t)(m) * DM + lane * 4; _Pragma("unroll") for (int j = 0; j < 4; ++j) DL[j] = *(const GAS u32x2*)(d_ + j * 256); } } while (0)
    if (mbeg < mend) NP_LOAD(mbeg, v, xb, dl);
    for (int m = mbeg; m < mend; ++m) {
        if (m + 1 < mend) NP_LOAD(m + 1, vn, xbn, dln);
        const int mi = modidx_of(m);
        if (mi != curmod) { curmod = mi; const float* mrow = mod + (size_t)mi * 6144;
#pragma unroll
            for (int j = 0; j < 4; ++j) { const int e = j * 256 + lane * 4; const f32x4 g = *(const f32x4*)(gsrc + e), sc = *(const f32x4*)(mrow + sc_off + e); ga[j] = g * (sc + 1.0f); sha[j] = *(const f32x4*)(mrow + sh_off + e);
                if (HAS_D) gtv[j] = *(const f32x4*)(gate + (size_t)mi * 6144 + e); } }
        float ss = 0.f;
#pragma unroll
        for (int j = 0; j < 4; ++j) {
            if (SRC_XR) { v[j][0] = bflo(xb[j].x); v[j][1] = bfhi(xb[j].x); v[j][2] = bflo(xb[j].y); v[j][3] = bfhi(xb[j].y); }
            if (HAS_D) { f32x4 dv; dv[0] = bflo(dl[j].x); dv[1] = bfhi(dl[j].x); dv[2] = bflo(dl[j].y); dv[3] = bfhi(dl[j].y); v[j] = v[j] + gtv[j] * dv;
                u32x2 w; w.x = pack2(v[j][0], v[j][1]); w.y = pack2(v[j][2], v[j][3]); *(u32x2*)(XR + (size_t)m * DM + j * 256 + lane * 4) = w; }
            ss += v[j][0] * v[j][0] + v[j][1] * v[j][1] + v[j][2] * v[j][2] + v[j][3] * v[j][3];
        }
        ss = wave_sum(ss);
        const float rstd = rsqrtf(ss * (1.0f / DM) + EPS);
        float d8[8];
#pragma unroll
        for (int q = 0; q < 8; ++q) d8[q] = 0.f;
        if (MODE == 5) {
            f32x4 hh[4]; float am = 0.f;
#pragma unroll
            for (int j = 0; j < 4; ++j) { hh[j] = v[j] * rstd * ga[j] + sha[j]; am = fmaxf(am, fmaxf(fmaxf(fabsf(hh[j][0]), fabsf(hh[j][1])), fmaxf(fabsf(hh[j][2]), fabsf(hh[j][3])))); }
            am = fmaxf(wave_max_dpp(am), 1.0e-20f);
            const float inv = 127.0f / am;
#pragma unroll
            for (int j = 0; j < 4; ++j) *(unsigned*)((unsigned char*)HB + (size_t)m * DM + j * 256 + lane * 4) = pack4_i8(hh[j][0] * inv, hh[j][1] * inv, hh[j][2] * inv, hh[j][3] * inv);
            if (lane == 0) ((float*)(F.ws + WS_RS))[m] = am * (1.0f / 127.0f);
        }
        f32x4 hq[4]; float amq = 0.f; (void)hq;
        if (MODE != 5) {
#pragma unroll
        for (int j = 0; j < 4; ++j) {
            const int e = j * 256 + lane * 4;
            f32x4 h = v[j] * rstd * ga[j] + sha[j];
            if (MODE == 2) *(unsigned*)((unsigned char*)HB + (size_t)m * DM + e) = pack4_fp8(h[0], h[1], h[2], h[3]);
            else if (MODE == 6) { hq[j] = h; amq = fmaxf(amq, fmaxf(fmaxf(fabsf(h[0]), fabsf(h[1])), fmaxf(fabsf(h[2]), fabsf(h[3])))); }
            else { u32x2 w; w.x = pack2(h[0], h[1]); w.y = pack2(h[2], h[3]); *(u32x2*)(HB + (size_t)m * DM + e) = w; }
            if (M0 || MODE == 2) {
#pragma unroll
                for (int i = 0; i < 4; ++i) {
#pragma unroll
                    for (int q = 0; q < 4; ++q) { d8[q] += h[i] * wx[j * 4 + i][0][q]; d8[4 + q] += h[i] * wx[j * 4 + i][1][q]; } }
            }
        }
        }
        if (MODE == 6) { amq = fmaxf(wave_max_dpp(amq), 1.0e-20f); const float inv = 127.0f / amq;
#pragma unroll
            for (int j = 0; j < 4; ++j) *(unsigned*)((unsigned char*)HB + (size_t)m * DM + j * 256 + lane * 4) = pack4_i8(hq[j][0] * inv, hq[j][1] * inv, hq[j][2] * inv, hq[j][3] * inv);
            if (lane == 0) ((float*)(F.ws + WS_RS))[m] = amq * (1.0f / 127.0f); }
        float dred = 0.f;
        if (M0 || MODE == 2) {
            const bool h5 = (lane & 32) != 0, h4 = (lane & 16) != 0, h3 = (lane & 8) != 0;
            float a4[4];
#pragma unroll
            for (int q = 0; q < 4; ++q) { const float keep = h5 ? d8[4 + q] : d8[q], send = h5 ? d8[q] : d8[4 + q]; a4[q] = keep + __shfl_xor(send, 32); }
            float a2[2];
#pragma unroll
            for (int q = 0; q < 2; ++q) { const float keep = h4 ? a4[2 + q] : a4[q], send = h4 ? a4[q] : a4[2 + q]; a2[q] = keep + __shfl_xor(send, 16); }
            { const float keep = h3 ? a2[1] : a2[0], send = h3 ? a2[0] : a2[1]; dred = keep + __shfl_xor(send, 8); }
            dred = row8_sum(dred);
        }
        if (M0) {
            if ((lane & 7) == 0) DT[(size_t)m * 8 + (lane >> 3)] = dred;
        }
        if (MODE == 2) {
#pragma unroll
            for (int q = 0; q < 8; ++q) d8[q] = __shfl(dred, 8 * q);
            int i1 = 0; float v1 = d8[0];
#pragma unroll
            for (int q = 1; q < 8; ++q) if (d8[q] > v1) { v1 = d8[q]; i1 = q; }
            int i2 = -1; float v2 = -3.0e38f;
#pragma unroll
            for (int q = 0; q < 8; ++q) if (q != i1 && d8[q] > v2) { v2 = d8[q]; i2 = q; }
            if (lane == 0) {
                const float g1 = 1.0f / (1.0f + __expf(v2 - v1));
                int* te = (int*)(F.ws + WS_ROUTE); float* tg = (float*)(te + 4 * ML);
                te[2 * m] = i1; te[2 * m + 1] = i2; tg[2 * m] = g1; tg[2 * m + 1] = 1.0f - g1;
            }
            if (lane == m - mbeg) { my_i1 = i1; my_i2 = i2; }
        }
#pragma unroll
        for (int j = 0; j < 4; ++j) { v[j] = vn[j]; xb[j] = xbn[j]; dl[j] = dln[j]; }
    }
#undef NP_LOAD
    if (MODE == 2) {
        LAS unsigned* lc = (LAS unsigned*)F.lds;
        __syncthreads();
        if (tid < 16) lc[tid] = 0u;
        __syncthreads();
        unsigned wbase1 = 0u, rank1 = 0u, rank2 = 0u; unsigned n1mine = 0u;
        const unsigned long long lt = (lane == 0) ? 0ull : (~0ull >> (64 - lane));
#pragma unroll
        for (int e = 0; e < 8; ++e) {
            const unsigned long long m1 = __ballot(my_i1 == e), m2 = __ballot(my_i2 == e);
            const unsigned c1 = (unsigned)__popcll(m1), c2 = (unsigned)__popcll(m2);
            unsigned wb = 0u;
            if (lane == 0 && (c1 + c2) != 0u) wb = __hip_atomic_fetch_add(lc + e, c1 + c2, __ATOMIC_RELAXED, __HIP_MEMORY_SCOPE_WORKGROUP);
            wb = (unsigned)__shfl((int)wb, 0);
            if (my_i1 == e) { wbase1 = wb; rank1 = (unsigned)__popcll(m1 & lt); }
            if (my_i2 == e) { n1mine = wb + c1; rank2 = (unsigned)__popcll(m2 & lt); }
        }
        __syncthreads();
        if (tid < 8) { const unsigned c = lc[tid]; lc[8 + tid] = c ? atomicAdd((unsigned*)(F.ws + WS_CTL) + CW_CNT + tid * 64, c) : 0u; }
        __syncthreads();
        if (my_i1 >= 0) { const int m = mbeg + lane; int* liste = (int*)(F.ws + WS_LISTE);
            liste[my_i1 * 65536 + (int)(lc[8 + my_i1] + wbase1 + rank1)] = 2 * m; liste[my_i2 * 65536 + (int)(lc[8 + my_i2] + n1mine + rank2)] = 2 * m + 1; }
        __syncthreads();
    }
}

constexpr int SS_LD = 272;
constexpr int SS_BM = 0, SS_CM = 128 * SS_LD, SS_BT = 2 * 128 * SS_LD, SS_XT = 3 * 128 * SS_LD, SS_HS = SS_XT + 64 * SS_LD, SS_AC = SS_HS + 64 * SS_LD, SS_DT = SS_AC + 512, SS_SC = SS_DT + 512;
static_assert(SS_SC + 512 <= LDSCTL_OFF, "ssd LDS map");
template <int V> struct IntC { static constexpr int value = V; };
template <int L>
__device__ __forceinline__ void ssd_scan_mfma(const Frame& F, bf16* Yd) {
    PHASE_IDS
    const bf16* PR = (const bf16*)(F.ws + WS_PRB);
    const float* DT = (const float*)(F.ws + WS_DT);
    LAS unsigned char* lb = F.lds;
    LAS float* acum = (LAS float*)(lb + SS_AC); LAS float* dtv = (LAS float*)(lb + SS_DT); LAS float* scl = (LAS float*)(lb + SS_SC);
    const float* cw = inptr(F, I_SCW) + (size_t)L * 3 * 768; const float* cb = inptr(F, I_SCB) + (size_t)L * 768;
    const int lq = lane & 15, g = lane >> 4;
    for (int item = F.bid; item < NB * 2 * 4; item += F.G) {
        const int b = item >> 3, d = (item >> 2) & 1, hd = item & 3, grp = hd >> 1;
        const float a = -__expf(inptr(F, I_SALOG)[(L * 2 + d) * 4 + hd]);
        const float dtb = inptr(F, I_SDTB)[(L * 2 + d) * 4 + hd];
        const float dsk = (d == 0) ? inptr(F, I_SD)[L * 4 + hd] : 0.f;
        const int xix = hd * 64 + lane, xib = 256 + grp * 128 + 2 * lane, xic = 512 + grp * 128 + 2 * lane;
        const float wx0 = cw[xix], wx1 = cw[768 + xix], wx2 = cw[1536 + xix], bx = cb[xix];
        const float wb00 = cw[xib], wb01 = cw[768 + xib], wb02 = cw[1536 + xib], bb0 = cb[xib], wb10 = cw[xib + 1], wb11 = cw[768 + xib + 1], wb12 = cw[1536 + xib + 1], bb1 = cb[xib + 1];
        const float wc00 = cw[xic], wc01 = cw[768 + xic], wc02 = cw[1536 + xic], bc0 = cb[xic], wc10 = cw[xic + 1], wc11 = cw[768 + xic + 1], wc12 = cw[1536 + xic + 1], bc1 = cb[xic + 1];
        f32x4 Hacc[4];
#pragma unroll
        for (int pt = 0; pt < 4; ++pt) Hacc[pt] = (f32x4){0.f, 0.f, 0.f, 0.f};
        __syncthreads();
        for (int i = tid; i < 64 * SS_LD / 4; i += 512) ((LAS unsigned*)(lb + SS_HS))[i] = 0u;
#define SSD_GEOM(chn) const bool isctx = (chn) < 2; const int Ls = isctx ? 256 : 2048, rowbase = isctx ? ML + b * 256 : b * 2048, sb = isctx ? (chn) * 128 : ((chn) - 2) * 128; const int p0 = d ? Ls - 128 - sb : sb;
        unsigned xr[18], br[18], cr[18]; float dtr0 = 0.f, dtr1 = 0.f;
#define SSD_PREFETCH(chn) do { SSD_GEOM(chn) \
            if (wave == 0) { const int pos0 = d ? p0 + 127 - 2 * lane : p0 + 2 * lane, pos1 = d ? pos0 - 1 : pos0 + 1; \
                dtr0 = DT[(size_t)(rowbase + pos0) * 8 + d * 4 + hd]; dtr1 = DT[(size_t)(rowbase + pos1) * 8 + d * 4 + hd]; } \
            const int pw = p0 + 16 * wave - 1; const bool z_lo = (pw < 0), z_hi = (pw + 17 >= Ls); \
            const bf16* pl = PR + (size_t)rowbase * NPR + C_XBC; \
            _Pragma("unroll") for (int k = 0; k < 18; ++k) { const int pos = min(max(pw + k, 0), Ls - 1); const bf16* pp = pl + (size_t)pos * NPR; \
                xr[k] = (unsigned)pp[xix]; br[k] = *(const unsigned*)(pp + xib); cr[k] = *(const unsigned*)(pp + xic); } \
            if (z_lo) { xr[0] = 0u; br[0] = 0u; cr[0] = 0u; } \
            if (z_hi) { xr[17] = 0u; br[17] = 0u; cr[17] = 0u; } } while (0)
        SSD_PREFETCH(0);
#pragma nounroll
        for (int ch = 0; ch < 18; ++ch) {
            SSD_GEOM(ch)
            (void)Ls; (void)sb;
            if (wave == 0) {
                const float dt0 = softplus_f(dtr0 + dtb), dt1 = softplus_f(dtr1 + dtb);
                const float la0 = dt0 * a, ps = la0 + dt1 * a;
                const float v = wave_scan_incl(ps, lane);
                const float base = v - ps;
                acum[2 * lane] = base + la0; acum[2 * lane + 1] = base + ps; dtv[2 * lane] = dt0; dtv[2 * lane + 1] = dt1;
                const float acT = __shfl(v, 63);
                scl[2 * lane] = dt0 * __expf(acT - (base + la0)); scl[2 * lane + 1] = dt1 * __expf(acT - (base + ps));
            }
            __syncthreads();
            { auto stage = [&](auto dc) {
                  constexpr int D = decltype(dc)::value;
                  unsigned px[4], pb0[4], pb1[4]; float xprev = 0.f, t0prev = 0.f, t1prev = 0.f;
                  const int i0b = (D ? 112 - 16 * wave : 16 * wave) * 2;
#pragma unroll
                  for (int k = 0; k < 16; ++k) {
                      const int li = 16 * wave + k, i = D ? 127 - li : li;
                      const float xa = silu_f(wx0 * bf2f(xr[k]) + wx1 * bf2f(xr[k + 1]) + wx2 * bf2f(xr[k + 2]) + bx);
                      const float b0 = silu_f(wb00 * bflo(br[k]) + wb01 * bflo(br[k + 1]) + wb02 * bflo(br[k + 2]) + bb0), b1 = silu_f(wb10 * bfhi(br[k]) + wb11 * bfhi(br[k + 1]) + wb12 * bfhi(br[k + 2]) + bb1);
                      const float c0 = silu_f(wc00 * bflo(cr[k]) + wc01 * bflo(cr[k + 1]) + wc02 * bflo(cr[k + 2]) + bc0), c1 = silu_f(wc10 * bfhi(cr[k]) + wc11 * bfhi(cr[k + 1]) + wc12 * bfhi(cr[k + 2]) + bc1);
                      const float sc = scl[i];
                      *(LAS unsigned*)(lb + SS_BM + i * SS_LD + lane * 4) = pack2(b0, b1);
                      *(LAS unsigned*)(lb + SS_CM + i * SS_LD + lane * 4) = pack2(c0, c1);
                      const float t0 = b0 * sc, t1 = b1 * sc;
                      if (k & 1) { const int q = (k >> 1) & 3; px[q] = D ? pack2(xa, xprev) : pack2(xprev, xa); pb0[q] = D ? pack2(t0, t0prev) : pack2(t0prev, t0); pb1[q] = D ? pack2(t1, t1prev) : pack2(t1prev, t1); }
                      else { xprev = xa; t0prev = t0; t1prev = t1; }
                      if ((k & 7) == 7) {
                          const int ob = i0b + (D ? 16 * (1 - (k >> 3)) : 16 * (k >> 3));
#define SSD_W1(base, P) *(LAS u32x4*)(lb + (base) + ob) = D ? (u32x4){P[3], P[2], P[1], P[0]} : (u32x4){P[0], P[1], P[2], P[3]}
                          SSD_W1(SS_XT + lane * SS_LD, px); SSD_W1(SS_BT + (2 * lane) * SS_LD, pb0); SSD_W1(SS_BT + (2 * lane + 1) * SS_LD, pb1);
#undef SSD_W1
                          __builtin_amdgcn_sched_barrier(0);
                      }
                  }
              };
              if (d) stage(IntC<1>{}); else stage(IntC<0>{}); }
            __syncthreads();
            if (ch + 1 < 18) SSD_PREFETCH(ch + 1);
            {
                const int lt = wave < 4 ? wave : 11 - wave;
                bf16x8 Cf[4];
#pragma unroll
                for (int kk = 0; kk < 4; ++kk) Cf[kk] = *(const LAS bf16x8*)(lb + SS_CM + (16 * lt + lq) * SS_LD + (32 * kk + 8 * g) * 2);
                if (!(L == 1 && ch < 2)) {
                f32x4 Ya[4];
#pragma unroll
                for (int pt = 0; pt < 4; ++pt) { Ya[pt] = (f32x4){0.f, 0.f, 0.f, 0.f};
                    bf16x8 Hf[4];
#pragma unroll
                    for (int kk = 0; kk < 4; ++kk) Hf[kk] = *(const LAS bf16x8*)(lb + SS_HS + (16 * pt + lq) * SS_LD + (32 * kk + 8 * g) * 2);
                    __builtin_amdgcn_sched_barrier(0);
#pragma unroll
                    for (int kk = 0; kk < 4; ++kk) Ya[pt] = __builtin_amdgcn_mfma_f32_16x16x32_bf16(Hf[kk], Cf[kk], Ya[pt], 0, 0, 0); }
                const int l = 16 * lt + lq; const float acl = acum[l], el = __expf(acl);
#pragma unroll
                for (int pt = 0; pt < 4; ++pt) Ya[pt] *= el;
#pragma nounroll
                for (int sc = 0; sc <= (lt >> 1); ++sc) {
                    f32x4 G0 = (f32x4){0.f, 0.f, 0.f, 0.f}, G1 = (f32x4){0.f, 0.f, 0.f, 0.f};
                    const int srow0 = 32 * sc + 8 * (lq >> 2) + (lq & 3);
                    { bf16x8 A0[4], A1[4];
#pragma unroll
                      for (int kk = 0; kk < 4; ++kk) { A0[kk] = *(const LAS bf16x8*)(lb + SS_BM + srow0 * SS_LD + (32 * kk + 8 * g) * 2); A1[kk] = *(const LAS bf16x8*)(lb + SS_BM + (srow0 + 4) * SS_LD + (32 * kk + 8 * g) * 2); }
                      __builtin_amdgcn_sched_barrier(0);
#pragma unroll
                      for (int kk = 0; kk < 4; ++kk) { G0 = __builtin_amdgcn_mfma_f32_16x16x32_bf16(A0[kk], Cf[kk], G0, 0, 0, 0); G1 = __builtin_amdgcn_mfma_f32_16x16x32_bf16(A1[kk], Cf[kk], G1, 0, 0, 0); } }
                    const int s0 = 32 * sc + 8 * g;
                    const f32x4 as0 = *(const LAS f32x4*)(acum + s0), as1 = *(const LAS f32x4*)(acum + s0 + 4), ds0 = *(const LAS f32x4*)(dtv + s0), ds1 = *(const LAS f32x4*)(dtv + s0 + 4);
                    float pv[8];
#pragma unroll
                    for (int e = 0; e < 4; ++e) { const int sA = s0 + e, sB = s0 + 4 + e;
                        float vA = G0[e] * __expf(acl - as0[e]) * ds0[e], vB = G1[e] * __expf(acl - as1[e]) * ds1[e];
                        vA = (sA == l) ? vA + dsk : vA; vB = (sB == l) ? vB + dsk : vB;
                        pv[e] = (sA <= l) ? vA : 0.f; pv[4 + e] = (sB <= l) ? vB : 0.f; }
                    u32x4 pw4; pw4.x = pack2(pv[0], pv[1]); pw4.y = pack2(pv[2], pv[3]); pw4.z = pack2(pv[4], pv[5]); pw4.w = pack2(pv[6], pv[7]);
                    const bf16x8 pfr = __builtin_bit_cast(bf16x8, pw4);
                    { bf16x8 Xf[4];
#pragma unroll
                      for (int pt = 0; pt < 4; ++pt) Xf[pt] = *(const LAS bf16x8*)(lb + SS_XT + (16 * pt + lq) * SS_LD + s0 * 2);
                      __builtin_amdgcn_sched_barrier(0);
#pragma unroll
                      for (int pt = 0; pt < 4; ++pt) Ya[pt] = __builtin_amdgcn_mfma_f32_16x16x32_bf16(Xf[pt], pfr, Ya[pt], 0, 0, 0); }
                }
                { const int pos = d ? p0 + 127 - l : p0 + l; bf16* yp = Yd + ((size_t)d * MT + rowbase + pos) * 256 + hd * 64 + 4 * g;
#pragma unroll
                  for (int pt = 0; pt < 4; ++pt) { u32x2 yw; yw.x = pack2_acc(Ya[pt][0], Ya[pt][1]); yw.y = pack2_acc(Ya[pt][2], Ya[pt][3]); *(u32x2*)(yp + 16 * pt) = yw; } }
                }
                const float dA = __expf(acum[127]);
#pragma unroll
                for (int pt = 0; pt < 4; ++pt) Hacc[pt] *= dA;
#pragma unroll
                for (int kk = 0; kk < 4; ++kk) {
                    bf16x8 Xf[4]; const bf16x8 Bf = *(const LAS bf16x8*)(lb + SS_BT + (16 * wave + lq) * SS_LD + (32 * kk + 8 * g) * 2);
#pragma unroll
                    for (int pt = 0; pt < 4; ++pt) Xf[pt] = *(const LAS bf16x8*)(lb + SS_XT + (16 * pt + lq) * SS_LD + (32 * kk + 8 * g) * 2);
                    __builtin_amdgcn_sched_barrier(0);
#pragma unroll
                    for (int pt = 0; pt < 4; ++pt) Hacc[pt] = __builtin_amdgcn_mfma_f32_16x16x32_bf16(Bf, Xf[pt], Hacc[pt], 0, 0, 0);
                }
            }
            __syncthreads();
#pragma unroll
            for (int pt = 0; pt < 4; ++pt) { u32x2 hw; hw.x = pack2_acc(Hacc[pt][0], Hacc[pt][1]); hw.y = pack2_acc(Hacc[pt][2], Hacc[pt][3]);
                *(LAS u32x2*)(lb + SS_HS + (16 * pt + lq) * SS_LD + (16 * wave + 4 * g) * 2) = hw; }
        }
#undef SSD_PREFETCH
#undef SSD_GEOM
        __syncthreads();
    }
}

constexpr int AW_WIN = 0, AW_CK = 73728, AW_CV = AW_CK + 32768, AW_RPB = AW_CV + 32768;
static_assert(AW_RPB + 4 * 465 * 4 <= LDSCTL_OFF, "attention LDS map");
__device__ __forceinline__ int aw_swzk(int key) { return (key & 7) ^ ((key >> 3) & 3); }
template <int L>
__device__ __forceinline__ void attn_phase(const Frame& F) {
    PHASE_IDS
    const bf16* PR = (const bf16*)(F.ws + WS_PRB); const bf16* VT = (const bf16*)(F.ws + WS_VT); bf16* O = (bf16*)(F.ws + WS_HB);
    LAS unsigned char* lb = F.lds;
    LAS float* rpbL = (LAS float*)(F.lds + AW_RPB);
    __syncthreads();
    for (int i = tid; i < 4 * 465; i += 512) rpbL[i] = inptr(F, I_RPB)[(size_t)L * 4 * 465 + i] * 1.44269504f;
    for (int item = F.bid; item < NB * 4 * 2; item += F.G) {
        const int b = item >> 3, h = (item >> 1) & 3, hf = item & 1;
        __syncthreads();
        int tv = wave * 64 + lane_id_fresh();
#pragma unroll
        for (int i = 0; i < 4; ++i) { const int p = tv + 512 * i;
            { const int key = p >> 3, ch = p & 7; *(LAS u32x4*)(lb + AW_CK + key * 128 + ((ch ^ aw_swzk(key)) << 4)) = *(const u32x4*)(PR + (size_t)(ML + b * 256 + key) * NPR + C_K + h * 64 + ch * 8); }
            { const int vq = p & 3, dim = (p >> 2) & 63, cc = p >> 8; *(LAS u32x4*)(lb + AW_CV + cc * 4096 + dim * 64 + ((vq ^ ((dim >> 2) & 3)) << 4)) = *(const u32x4*)(VT + (size_t)(b * 256 + h * 64 + dim) * VT_LD + cc * 32 + vq * 8); } }
        u32x4 pre[9];
#define AW_KPREF(srA_) do { _Pragma("unroll") for (int i_ = 0; i_ < 9; ++i_) { const int p_ = tv + 512 * i_, key_ = p_ >> 3, ch_ = p_ & 7; const int kr_ = min((srA_) + (key_ >> 6), 31); \
            pre[i_] = *(const u32x4*)(PR + (size_t)(b * 2048 + kr_ * 64 + (key_ & 63)) * NPR + C_K + h * 64 + ch_ * 8); } } while (0)
#define AW_VPREF(srA_, lo_, hi_) do { _Pragma("unroll") for (int i_ = (lo_); i_ < (hi_); ++i_) { const int p_ = tv + 512 * i_, vc_ = ((p_ >> 8) << 2) + (p_ & 3), dim_ = (p_ >> 2) & 63; \
            pre[i_] = *(const u32x4*)(VT + (size_t)(b * 256 + h * 64 + dim_) * VT_LD + 256 + (srA_) * 64 + vc_ * 8); } } while (0)
        AW_KPREF(min(max(16 * hf - 4, 0), 24));
#pragma nounroll
        for (int it = 0; it < 8; ++it) {
            const int r0 = 16 * hf + 2 * it, srA = min(max(r0 - 4, 0), 24);
            const int ln = lane_id_fresh(); const int qi = ln & 15, g = ln >> 4; tv = wave * 64 + ln;
            const int xk0 = 8 * (qi >> 2) + (qi & 3);
            const int r = r0 + (wave >> 2), j = wave & 3, sr = min(max(r - 4, 0), 24), roff = sr - srA;
            const int band0 = min(max(16 * j - 8, 0), 32);
            __syncthreads();
#pragma unroll
            for (int i = 0; i < 9; ++i) { const int p = tv + 512 * i, key = p >> 3, ch = p & 7; *(LAS u32x4*)(lb + AW_WIN + key * 128 + ((ch ^ aw_swzk(key)) << 4)) = pre[i]; }
            const int qrow = b * 2048 + r * 64 + 16 * j + qi;
            const bf16* qp = PR + (size_t)qrow * NPR + C_Q + h * 64 + 8 * g;
            const bf16x8 q0 = *(const bf16x8*)qp, q1 = *(const bf16x8*)(qp + 32);
            int kwa[2][2], kca[2][2];
#pragma unroll
            for (int t = 0; t < 2; ++t) { const int kw = roff * 64 + band0 + xk0 + 4 * t, swt = aw_swzk(kw), kc0 = xk0 + 4 * t, swc = aw_swzk(kc0);
                kwa[t][0] = AW_WIN + kw * 128 + ((g ^ swt) << 4); kwa[t][1] = AW_WIN + kw * 128 + (((g + 4) ^ swt) << 4);
                kca[t][0] = AW_CK + kc0 * 128 + ((g ^ swc) << 4); kca[t][1] = AW_CK + kc0 * 128 + (((g + 4) ^ swc) << 4); }
            f32x4 S[16][2];
#pragma unroll
            for (int cp = 0; cp < 16; cp += 2) {
                if (cp == 8) { __syncthreads(); }
                bf16x8 kf[2][2][2];
#pragma unroll
                for (int u = 0; u < 2; ++u) { const int c = (cp + u + 8) & 15;
#pragma unroll
                    for (int t = 0; t < 2; ++t) { kf[u][t][0] = *(const LAS bf16x8*)(lb + ((c < 8) ? kwa[t][0] + c * 8192 : kca[t][0] + (c - 8) * 4096)); kf[u][t][1] = *(const LAS bf16x8*)(lb + ((c < 8) ? kwa[t][1] + c * 8192 : kca[t][1] + (c - 8) * 4096)); } }
                __builtin_amdgcn_sched_barrier(0);
#pragma unroll
                for (int u = 0; u < 2; ++u) { const int c = (cp + u + 8) & 15;
#pragma unroll
                    for (int t = 0; t < 2; ++t) { const f32x4 z = (f32x4){0.f, 0.f, 0.f, 0.f};
                        S[c][t] = __builtin_amdgcn_mfma_f32_16x16x32_bf16(kf[u][t][0], q0, z, 0, 0, 0); S[c][t] = __builtin_amdgcn_mfma_f32_16x16x32_bf16(kf[u][t][1], q1, S[c][t], 0, 0, 0); } }
                __builtin_amdgcn_sched_barrier(0);
            }
            AW_VPREF(srA, 0, 5);
            float mx = -3.0e38f, mxc = -3.0e38f;
            { const int cq = 16 * j + qi, scq = min(max(cq - 8, 0), 48);
              int bidx[8]; bool vld[8];
#pragma unroll
              for (int te = 0; te < 8; ++te) { const int kc = band0 + 8 * g + te; vld[te] = (kc >= scq) && (kc < scq + 16); bidx[te] = h * 465 + (sr - r + 7) * 31 + min(max(kc - cq + 15, 0), 30); }
#pragma unroll
              for (int c = 0; c < 16; ++c) {
                  if (c < 8) {
                      float rb[8];
#pragma unroll
                      for (int te = 0; te < 8; ++te) rb[te] = *(const volatile LAS float*)(rpbL + bidx[te] + c * 31);
#pragma unroll
                      for (int t = 0; t < 2; ++t)
#pragma unroll
                          for (int e = 0; e < 4; ++e) { const float sv = vld[t * 4 + e] ? __builtin_fmaf(S[c][t][e], 0.125f * 1.44269504f, rb[t * 4 + e]) : -3.0e38f; S[c][t][e] = sv; mx = fmaxf(mx, sv); }
                  } else {
#pragma unroll
                      for (int t = 0; t < 2; ++t)
#pragma unroll
                          for (int e = 0; e < 4; ++e) mxc = fmaxf(mxc, S[c][t][e]);
                  }
              } }
            mx = fmaxf(mx, mxc * (0.125f * 1.44269504f));
            mx = fmaxf(mx, __shfl_xor(mx, 16)); mx = fmaxf(mx, __shfl_xor(mx, 32));
            float sum = 0.f;
            bf16x8 pf[16];
#pragma unroll
            for (int c = 0; c < 16; ++c) {
                float pv[8];
#pragma unroll
                for (int t = 0; t < 2; ++t)
#pragma unroll
                    for (int e = 0; e < 4; ++e) { pv[t * 4 + e] = __builtin_amdgcn_exp2f(c < 8 ? S[c][t][e] - mx : __builtin_fmaf(S[c][t][e], 0.125f * 1.44269504f, -mx)); sum += pv[t * 4 + e]; }
                u32x4 w; w.x = pack2(pv[0], pv[1]); w.y = pack2(pv[2], pv[3]); w.z = pack2(pv[4], pv[5]); w.w = pack2(pv[6], pv[7]);
                pf[c] = __builtin_bit_cast(bf16x8, w);
            }
            sum += __shfl_xor(sum, 16); sum += __shfl_xor(sum, 32);
            AW_VPREF(srA, 5, 9);
            __syncthreads();
#pragma unroll
            for (int i = 0; i < 9; ++i) { const int p = tv + 512 * i, vc = ((p >> 8) << 2) + (p & 3), dim = (p >> 2) & 63; *(LAS u32x4*)(lb + AW_WIN + vc * 1024 + dim * 16) = pre[i]; }
            if (it + 1 < 8) AW_KPREF(min(max(r0 + 2 - 4, 0), 24));
            int vwa[4], vca[4];
#pragma unroll
            for (int dt = 0; dt < 4; ++dt) { const int dim = 16 * dt + qi; vwa[dt] = AW_WIN + (roff * 8 + (band0 >> 3) + g) * 1024 + dim * 16; vca[dt] = AW_CV + dim * 64 + ((g ^ ((dim >> 2) & 3)) << 4); }
            f32x4 Oa[4];
#pragma unroll
            for (int dt = 0; dt < 4; ++dt) Oa[dt] = (f32x4){0.f, 0.f, 0.f, 0.f};
#pragma unroll
            for (int cp = 0; cp < 16; cp += 2) {
                if (cp == 8) { __syncthreads(); }
                bf16x8 vf[2][4];
#pragma unroll
                for (int u = 0; u < 2; ++u) { const int c = (cp + u + 8) & 15;
#pragma unroll
                    for (int dt = 0; dt < 4; ++dt) vf[u][dt] = *(const LAS bf16x8*)(lb + ((c < 8) ? vwa[dt] + c * 8192 : vca[dt] + (c - 8) * 4096)); }
                __builtin_amdgcn_sched_barrier(0);
#pragma unroll
                for (int u = 0; u < 2; ++u) { const int c = (cp + u + 8) & 15;
#pragma unroll
                    for (int dt = 0; dt < 4; ++dt) Oa[dt] = __builtin_amdgcn_mfma_f32_16x16x32_bf16(vf[u][dt], pf[c], Oa[dt], 0, 0, 0); }
                __builtin_amdgcn_sched_barrier(0);
            }
            const float inv = 1.0f / sum;
            bf16* op = O + (size_t)qrow * DM + 512 + h * 64 + 4 * g;
#pragma unroll
            for (int dt = 0; dt < 4; ++dt) { u32x2 w; w.x = pack2(Oa[dt][0] * inv, Oa[dt][1] * inv); w.y = pack2(Oa[dt][2] * inv, Oa[dt][3] * inv); *(u32x2*)(op + 16 * dt) = w; }
        }
#undef AW_KPREF
#undef AW_VPREF
        if (L == 0) {
            const int ln = lane_id_fresh(); const int qi = ln & 15, g = ln >> 4; const int xk0 = 8 * (qi >> 2) + (qi & 3);
            const int qrow = ML + b * 256 + 16 * (hf * 8 + wave) + qi;
            const bf16* qp = PR + (size_t)qrow * NPR + C_Q + h * 64 + 8 * g;
            const bf16x8 q0 = *(const bf16x8*)qp, q1 = *(const bf16x8*)(qp + 32);
            int kca[2][2], vca[4];
#pragma unroll
            for (int t = 0; t < 2; ++t) { const int kc0 = xk0 + 4 * t, swc = aw_swzk(kc0); kca[t][0] = AW_CK + kc0 * 128 + ((g ^ swc) << 4); kca[t][1] = AW_CK + kc0 * 128 + (((g + 4) ^ swc) << 4); }
#pragma unroll
            for (int dt = 0; dt < 4; ++dt) { const int dim = 16 * dt + qi; vca[dt] = AW_CV + dim * 64 + ((g ^ ((dim >> 2) & 3)) << 4); }
            f32x4 S[8][2]; float mx = -3.0e38f;
#pragma unroll
            for (int c = 0; c < 8; ++c)
#pragma unroll
                for (int t = 0; t < 2; ++t) {
                    const bf16x8 k0 = *(const LAS bf16x8*)(lb + kca[t][0] + c * 4096), k1 = *(const LAS bf16x8*)(lb + kca[t][1] + c * 4096);
                    const f32x4 z = (f32x4){0.f, 0.f, 0.f, 0.f};
                    S[c][t] = __builtin_amdgcn_mfma_f32_16x16x32_bf16(k0, q0, z, 0, 0, 0); S[c][t] = __builtin_amdgcn_mfma_f32_16x16x32_bf16(k1, q1, S[c][t], 0, 0, 0);
#pragma unroll
                    for (int e = 0; e < 4; ++e) { S[c][t][e] *= (0.125f * 1.44269504f); mx = fmaxf(mx, S[c][t][e]); } }
            mx = fmaxf(mx, __shfl_xor(mx, 16)); mx = fmaxf(mx, __shfl_xor(mx, 32));
            float sum = 0.f; f32x4 Oa[4];
#pragma unroll
            for (int dt = 0; dt < 4; ++dt) Oa[dt] = (f32x4){0.f, 0.f, 0.f, 0.f};
#pragma unroll
            for (int c = 0; c < 8; ++c) { float pv[8];
#pragma unroll
                for (int t = 0; t < 2; ++t)
#pragma unroll
                    for (int e = 0; e < 4; ++e) { pv[t * 4 + e] = __builtin_amdgcn_exp2f(S[c][t][e] - mx); sum += pv[t * 4 + e]; }
                u32x4 w; w.x = pack2(pv[0], pv[1]); w.y = pack2(pv[2], pv[3]); w.z = pack2(pv[4], pv[5]); w.w = pack2(pv[6], pv[7]);
                const bf16x8 pfc = __builtin_bit_cast(bf16x8, w);
#pragma unroll
                for (int dt = 0; dt < 4; ++dt) Oa[dt] = __builtin_amdgcn_mfma_f32_16x16x32_bf16(*(const LAS bf16x8*)(lb + vca[dt] + c * 4096), pfc, Oa[dt], 0, 0, 0); }
            sum += __shfl_xor(sum, 16); sum += __shfl_xor(sum, 32);
            const float inv = 1.0f / sum;
            bf16* op = O + (size_t)qrow * DM + 512 + h * 64 + 4 * g;
#pragma unroll
            for (int dt = 0; dt < 4; ++dt) { u32x2 w; w.x = pack2(Oa[dt][0] * inv, Oa[dt][1] * inv); w.y = pack2(Oa[dt][2] * inv, Oa[dt][3] * inv); *(u32x2*)(op + 16 * dt) = w; }
        }
    }
    __syncthreads();
}
constexpr int PC_P_OFF = 48 * 256 * 4, PC_P_LD = 528;
template <int L>
__device__ __forceinline__ void poolconv_mfma(const Frame& F, int nrows) {
    PHASE_IDS
    const bf16* PR = (const bf16*)(F.ws + WS_PRB);
    bf16* O = (bf16*)(F.ws + WS_HB);
    LAS float* ut = (LAS float*)F.lds;
    LAS unsigned char* pl = F.lds + PC_P_OFF;
    const float* pw = inptr(F, I_POOLW) + (size_t)L * 4 * 64 * 64; const float* psc = inptr(F, I_POOLS) + L * 256; const float* cw = inptr(F, I_CONVW) + (size_t)L * 3 * 256;
    const int lq = lane & 15, g4 = lane >> 4, grp = wave & 3, tt = wave >> 2;
    bf16x8 Wf[4][2]; f32x4 scl[4];
#pragma unroll
    for (int nt = 0; nt < 4; ++nt) {
#pragma unroll
        for (int kk = 0; kk < 2; ++kk) { float w8[8];
#pragma unroll
            for (int e = 0; e < 8; ++e) w8[e] = pw[(grp * 64 + 32 * kk + 8 * g4 + e) * 64 + 16 * nt + lq];
            u32x4 pk; pk.x = pack2(w8[0], w8[1]); pk.y = pack2(w8[2], w8[3]); pk.z = pack2(w8[4], w8[5]); pk.w = pack2(w8[6], w8[7]); Wf[nt][kk] = __builtin_bit_cast(bf16x8, pk); }
        scl[nt] = *(const f32x4*)(psc + grp * 64 + 16 * nt + 4 * g4);
    }
    const int cp = tid & 127, seg = tid >> 7;
    const float cw00 = cw[2 * cp], cw01 = cw[256 + 2 * cp], cw02 = cw[512 + 2 * cp], cw10 = cw[2 * cp + 1], cw11 = cw[256 + 2 * cp + 1], cw12 = cw[512 + 2 * cp + 1];
    unsigned uw[12], hr[10], cr[10], bg[8];
#define PC_GEOM(item_) const int m0 = (item_) * 32; const bool lat = m0 < ML; const int Ls = lat ? 2048 : 256; const int seq0 = lat ? (m0 & ~2047) : ML + ((m0 - ML) & ~255); const int t0 = m0 - seq0;
#define PC_LOAD(item_) do { PC_GEOM(item_) \
        _Pragma("unroll") for (int it = 0; it < 12; ++it) { const int rr = it * 4 + seg, t = t0 - 8 + rr; uw[it] = 0u; if (t >= 0 && t < Ls) uw[it] = *(const unsigned*)(PR + (size_t)(seq0 + t) * NPR + C_POOL + 2 * cp); } \
        const int tb = t0 + 8 * seg - 1; \
        _Pragma("unroll") for (int k = 0; k < 10; ++k) { const int t = tb + k; const bool ok = (t >= 0) && (t < Ls); const bf16* pp = PR + (size_t)(seq0 + (ok ? t : 0)) * NPR + 2 * cp; \
            hr[k] = ok ? *(const unsigned*)(pp + C_CONVH) : 0u; cr[k] = ok ? *(const unsigned*)(pp + C_CONVC) : 0u; if (k >= 1 && k <= 8) bg[k - 1] = *(const unsigned*)(pp + C_CONVB); } } while (0)
    if (F.bid < nrows / 32) PC_LOAD(F.bid);
    for (int item = F.bid; item < nrows / 32; item += F.G) {
        PC_GEOM(item)
        (void)lat;
        __syncthreads();
#pragma unroll
        for (int it = 0; it < 12; ++it) { const int rr = it * 4 + seg; ut[rr * 256 + 2 * cp] = bflo(uw[it]); ut[rr * 256 + 2 * cp + 1] = bfhi(uw[it]); }
        { float p0[10], p1[10];
#pragma unroll
          for (int k = 0; k < 10; ++k) { p0[k] = bflo(hr[k]) * bflo(cr[k]); p1[k] = bfhi(hr[k]) * bfhi(cr[k]); }
#pragma unroll
          for (int k = 0; k < 8; ++k) { const float y0 = bflo(bg[k]) * (cw00 * p0[k] + cw01 * p0[k + 1] + cw02 * p0[k + 2]), y1 = bfhi(bg[k]) * (cw10 * p1[k] + cw11 * p1[k + 1] + cw12 * p1[k + 2]);
              *(unsigned*)(O + (size_t)(m0 + 8 * seg + k) * DM + 256 + 2 * cp) = pack2(y0, y1); } }
        if (item + F.G < nrows / 32) PC_LOAD(item + F.G);
        __syncthreads();
        { const int c = tid & 255, sg = tid >> 8, gg = c >> 6, hw = 1 << gg;
          int t = t0 + 16 * sg; float S = 0.f;
          for (int q = -hw; q < hw; ++q) S += ut[(16 * sg + 8 + q) * 256 + c];
#pragma unroll 4
          for (int i = 0; i < 16; ++i, ++t) { const int rr = 16 * sg + i + 8;
              const int cnt = min(t + hw, Ls) - max(t - hw, 0);
              *(LAS bf16*)(pl + (16 * sg + i) * PC_P_LD + c * 2) = f2bf(S / (float)cnt - ut[rr * 256 + c]);
              S += ut[(rr + hw) * 256 + c] - ut[(rr - hw) * 256 + c]; } }
        __syncthreads();
        { const bf16x8 B0 = *(const LAS bf16x8*)(pl + (16 * tt + lq) * PC_P_LD + (grp * 64 + 8 * g4) * 2), B1 = *(const LAS bf16x8*)(pl + (16 * tt + lq) * PC_P_LD + (grp * 64 + 32 + 8 * g4) * 2);
          bf16* op = O + (size_t)(m0 + 16 * tt + lq) * DM + grp * 64 + 4 * g4;
#pragma unroll
          for (int nt = 0; nt < 4; ++nt) { f32x4 D = (f32x4){0.f, 0.f, 0.f, 0.f};
              D = __builtin_amdgcn_mfma_f32_16x16x32_bf16(Wf[nt][0], B0, D, 0, 0, 0); D = __builtin_amdgcn_mfma_f32_16x16x32_bf16(Wf[nt][1], B1, D, 0, 0, 0);
              D *= scl[nt]; u32x2 w; w.x = pack2(D[0], D[1]); w.y = pack2(D[2], D[3]); *(u32x2*)(op + 16 * nt) = w; } }
    }
    __syncthreads();
#undef PC_LOAD
#undef PC_GEOM
}
template <int L>
__device__ __forceinline__ void ssd_combine(const Frame& F, const bf16* Yd, int nrows) {
    PHASE_IDS
    const bf16* PR = (const bf16*)(F.ws + WS_PRB);
    bf16* O = (bf16*)(F.ws + WS_HB);
    const f32x4 ng = *(const f32x4*)(inptr(F, I_SNG) + L * 256 + lane * 4);
    for (int m = F.bid * 8 + wave; m < nrows; m += F.G * 8) {
        const u32x2 y0w = *(const u32x2*)(Yd + (size_t)m * 256 + lane * 4), y1w = *(const u32x2*)(Yd + ((size_t)MT + m) * 256 + lane * 4);
        const f32x4 y0 = (f32x4){bflo(y0w.x), bfhi(y0w.x), bflo(y0w.y), bfhi(y0w.y)}, y1 = (f32x4){bflo(y1w.x), bfhi(y1w.x), bflo(y1w.y), bfhi(y1w.y)};
        const u32x2 zw = *(const u32x2*)(PR + (size_t)m * NPR + C_Z + lane * 4);
        f32x4 v; v[0] = (y0[0] + y1[0]) * silu_f(bflo(zw.x)); v[1] = (y0[1] + y1[1]) * silu_f(bfhi(zw.x)); v[2] = (y0[2] + y1[2]) * silu_f(bflo(zw.y)); v[3] = (y0[3] + y1[3]) * silu_f(bfhi(zw.y));
        const float ss = wave_sum(v[0] * v[0] + v[1] * v[1] + v[2] * v[2] + v[3] * v[3]);
        const float rstd = rsqrtf(ss * (1.0f / 256.0f) + EPS);
        u32x2 w; w.x = pack2(v[0] * rstd * ng[0], v[1] * rstd * ng[1]); w.y = pack2(v[2] * rstd * ng[2], v[3] * rstd * ng[3]);
        *(u32x2*)(O + (size_t)m * DM + 768 + lane * 4) = w;
    }
}
__device__ __forceinline__ void final_phase(const Frame& F) {
    PHASE_IDS
    const bf16* XR = (const bf16*)(F.ws + WS_XR);
    const bf16* Y = (const bf16*)F.out;
    const float* mod = (const float*)(F.ws + WS_MOD) + (size_t)1 * 33 * 6144 + 5 * 1024;
    const float* gfin = inptr(F, I_GFINAL);
    const int per = (ML + F.G * 8 - 1) / (F.G * 8), mbeg = (F.bid * 8 + wave) * per, mend = min(mbeg + per, ML);
    u32x2 xw[4], ya[4], yb[4], xwn[4], yan[4], ybn[4];
    f32x4 gfv[4];
#pragma unroll
    for (int j = 0; j < 4; ++j) gfv[j] = *(const f32x4*)(gfin + j * 256 + lane * 4);
#define FP_LOAD(m, XW, YA, YB) do { _Pragma("unroll") for (int j = 0; j < 4; ++j) { const int e = j * 256 + lane * 4; XW[j] = *(const GAS u32x2*)((const GAS bf16*)XR + (size_t)(m) * DM + e); \
        YA[j] = *(const GAS u32x2*)((const GAS bf16*)Y + (size_t)(2 * (m)) * DM + e); YB[j] = *(const GAS u32x2*)((const GAS bf16*)Y + (size_t)(2 * (m) + 1) * DM + e); } } while (0)
    if (mbeg < mend) FP_LOAD(mbeg, xw, ya, yb);
    for (int m = mbeg; m < mend; ++m) {
        if (m + 1 < mend) FP_LOAD(m + 1, xwn, yan, ybn);
        const float* grow = mod + (size_t)(m >> 11) * 6144;
        f32x4 v[4]; float ss = 0.f;
#pragma unroll
        for (int j = 0; j < 4; ++j) { const int e = j * 256 + lane * 4; const f32x4 g = *(const f32x4*)(grow + e);
            v[j][0] = bflo(xw[j].x) + g[0] * (bflo(ya[j].x) + bflo(yb[j].x)); v[j][1] = bfhi(xw[j].x) + g[1] * (bfhi(ya[j].x) + bfhi(yb[j].x));
            v[j][2] = bflo(xw[j].y) + g[2] * (bflo(ya[j].y) + bflo(yb[j].y)); v[j][3] = bfhi(xw[j].y) + g[3] * (bfhi(ya[j].y) + bfhi(yb[j].y));
            ss += v[j][0] * v[j][0] + v[j][1] * v[j][1] + v[j][2] * v[j][2] + v[j][3] * v[j][3]; }
        ss = wave_sum(ss);
        const float rstd = rsqrtf(ss * (1.0f / DM) + EPS);
#pragma unroll
        for (int j = 0; j < 4; ++j) { const int e = j * 256 + lane * 4; *(f32x4*)(F.out + (size_t)m * DM + e) = v[j] * rstd * gfv[j]; }
#pragma unroll
        for (int j = 0; j < 4; ++j) { xw[j] = xwn[j]; ya[j] = yan[j]; yb[j] = ybn[j]; }
    }
#undef FP_LOAD
}

constexpr int N_PHASES = 19;
#ifndef DUP
#define DUP 0
#endif
__global__ void __launch_bounds__(512, 2) fwd_kernel(Args args) {
    extern __shared__ __attribute__((aligned(16))) unsigned char lds_raw[];
    Frame F;
    F.lds = (LAS unsigned char*)lds_raw;
    F.G = gridDim.x; F.bid = blockIdx.x; F.wv = __builtin_amdgcn_readfirstlane(threadIdx.x >> 6);
    F.out = args.out; F.ws = args.ws;
    volatile LAS unsigned* ctlw = (volatile LAS unsigned*)(F.lds + LDSCTL_OFF);
    if (threadIdx.x < 4) ctlw[threadIdx.x] = 0u;
    { volatile LAS unsigned long long* tbl = (volatile LAS unsigned long long*)(F.lds + LDSCTL_OFF + 16);
#pragma unroll
      for (int i = 0; i < 26; ++i) if (threadIdx.x == 64 + i) tbl[i] = (unsigned long long)args.in[i]; }
    __syncthreads();
    const int lo = args.ph_lo, hi = args.ph_hi;
    const bool multi = (hi - lo) > 1;
    XcdBarrier bar; bar.bar = (unsigned*)(F.ws + WS_CTL) + CW_BAR; bar.x = 0; bar.st = ctlw;
    if (multi) bar = xcd_barrier_post((unsigned*)(F.ws + WS_CTL) + CW_BAR, ctlw);
#define IN(k) (lo <= (k) && (k) < hi)
#define SEAM(k) do { if (IN((k) + 1)) xcd_barrier(bar, F.wv); } while (0)
    unsigned char* wb = F.ws + WS_WB;
    bf16* HB = (bf16*)(F.ws + WS_HB); bf16* PRB = (bf16*)(F.ws + WS_PRB);
    const float* MOD = (const float*)(F.ws + WS_MOD);
    bf16* Yd = (bf16*)F.out;

    if (IN(0)) { p0_prologue(F); SEAM(0); }
    if (IN(1)) { conv_tiles(F, 0, 704, 0, 0, F.bid, F.G); norm_phase<0, 6, false, false>(F, MT, nullptr, nullptr); SEAM(1); }
    if (IN(2)) { pg8::DenseOrderT<true> S; S.init(MT, NPR, F.G, F.bid); pg8::EpiInProjI8 E{PRB, (bf16*)(F.ws + WS_VT), (const float*)(F.ws + WS_RS), (const float*)(F.ws + WS_CSIN)};
        pg8::gemm_phase<pg8::EpiInProjI8, pg8::DenseOrderT<true>, 2>(F.lds, F.wv, HB, (const bf16*)(wb + WB_IN), DM / 2, S, E);
        { int w, nw; if (tail_worker(F, (MT / 256) * (NPR / 256), w, nw)) conv_tiles(F, 1408, 256, 1920, 1408, w, nw); }
        SEAM(2); }
    if (IN(3)) { ssd_scan_mfma<0>(F, Yd); attn_phase<0>(F); poolconv_mfma<0>(F, MT); SEAM(3); }
    if (IN(4)) { ssd_combine<0>(F, Yd, MT); SEAM(4); }
    if (IN(5)) { pg8::DenseOrder S; S.init(MT, DM, F.G, F.bid); pg8::EpiResid<true> E{(bf16*)(F.ws + WS_XR), inptr(F, I_X), inptr(F, I_CTX), MOD + 2 * 1024};
        pg8::gemm_phase(F.lds, F.wv, HB, (const bf16*)(wb + WB_OUT), DM, S, E);
        { int w, nw; if (tail_worker(F, (MT / 256) * (DM / 256), w, nw)) conv_tiles(F, 3328, 704, 704, 704, w, nw); }
        SEAM(5); }
    if (IN(6)) { norm_phase<0, 5, true, false>(F, MT, nullptr, nullptr); SEAM(6); }
    if (IN(7)) { pg8::DenseOrderT<true> S; S.init(MT, 2 * DFF, F.G, F.bid); pg8::EpiSwigluI8 E{PRB, DFF, (const float*)(F.ws + WS_RS), (const float*)(F.ws + WS_CS), DFF};
        pg8::gemm_phase<pg8::EpiSwigluI8, pg8::DenseOrderT<true>, 2>(F.lds, F.wv, HB, (const bf16*)(wb + WB_GU), DM / 2, S, E);
        { int w, nw; if (tail_worker(F, (MT / 256) * (2 * DFF / 256), w, nw)) conv_tiles(F, 1664, 256, 0, 0, w, nw); }
        SEAM(7); }
    if (IN(8)) { pg8::DenseOrder S; S.init(MT, DM, F.G, F.bid); pg8::EpiResid<false> E{(bf16*)(F.ws + WS_XR), nullptr, nullptr, MOD + 5 * 1024};
        pg8::gemm_phase(F.lds, F.wv, PRB, (const bf16*)(wb + WB_DOWN), DFF, S, E);
        { int w, nw; if (tail_worker(F, (MT / 256) * (DM / 256), w, nw)) conv_tiles(F, 4032, 8448, 0, 0, w, nw); }
        SEAM(8); }
    if (IN(9)) { norm_phase<1, 6, true, false>(F, MT, nullptr, nullptr); SEAM(9); }
    if (IN(10)) { pg8::InProjL1OrderT<true> S; S.init(F.G, F.bid); pg8::EpiInProjI8 E{PRB, (bf16*)(F.ws + WS_VT), (const float*)(F.ws + WS_RS), (const float*)(F.ws + WS_CSIN) + NPR};
        pg8::gemm_phase<pg8::EpiInProjI8, pg8::InProjL1OrderT<true>, 2>(F.lds, F.wv, HB, (const bf16*)(wb + WB_IN + WB_IN_SZ), DM / 2, S, E); SEAM(10); }
    if (IN(11)) { ssd_scan_mfma<1>(F, Yd); attn_phase<1>(F); poolconv_mfma<1>(F, ML); SEAM(11); }
    if (IN(12)) { ssd_combine<1>(F, Yd, ML); SEAM(12); }
    if (IN(13)) { pg8::DenseOrder S; S.init(ML, DM, F.G, F.bid); pg8::EpiResid<false> E{(bf16*)(F.ws + WS_XR), nullptr, nullptr, MOD + 33 * 6144 + 2 * 1024};
        pg8::gemm_phase(F.lds, F.wv, HB, (const bf16*)(wb + WB_OUT + WB_OUT_SZ), DM, S, E); SEAM(13); }
    if (IN(14)) { norm_phase<1, 2, true, false>(F, ML, nullptr, nullptr); SEAM(14); }
    if (IN(16)) { pg8::MoeOrder<true> S; S.init((const unsigned*)(F.ws + WS_CTL) + CW_CNT, (const int*)(F.ws + WS_LISTE), WB_MGU_SZ, 2 * DFE, F.G, F.bid); pg8::EpiSwigluF8 E{F.ws + WS_PRB};
        pg8::gemm_phase<pg8::EpiSwigluF8, pg8::MoeOrder<true>, 1>(F.lds, F.wv, HB, (const bf16*)(wb + WB_MGU), DM / 2, S, E); SEAM(16); }
    if (IN(17)) { pg8::MoeOrder<false, true> S; S.init((const unsigned*)(F.ws + WS_CTL) + CW_CNT, (const int*)(F.ws + WS_LISTE), WB_MDOWN_SZ, DM, F.G, F.bid);
        pg8::EpiMoeOut E{(bf16*)F.out, (const int*)(F.ws + WS_LISTE), (const float*)(F.ws + WS_ROUTE) + 4 * ML};
        pg8::gemm_phase<pg8::EpiMoeOut, pg8::MoeOrder<false, true>, 1>(F.lds, F.wv, PRB, (const bf16*)(wb + WB_MDOWN), DFEP / 2, S, E); SEAM(17); }
    if (IN(18)) { final_phase(F); }
#undef IN
#undef SEAM
}

#ifndef N_LAUNCHES
#define N_LAUNCHES 1
#endif
extern "C" void kernel_launch(void* const* d_in, const int* in_sizes, int n_in, void* d_out, int out_size, void* d_ws, size_t ws_size, hipStream_t stream) {
    static int grid = 0;
    if (grid == 0) {
        if (n_in != 26 || out_size != ML * DM || ws_size < WS_END) { fprintf(stderr, "kernel_launch: unexpected shapes: n_in %d out %d ws %zu\n", n_in, out_size, ws_size); grid = -1; return; }
        int dev = 0, cus = 0, per_cu = 0;
        if (hipGetDevice(&dev) != hipSuccess || hipDeviceGetAttribute(&cus, hipDeviceAttributeMultiprocessorCount, dev) != hipSuccess) { grid = -1; return; }
        if (hipFuncSetAttribute((const void*)fwd_kernel, hipFuncAttributeMaxDynamicSharedMemorySize, LDS_BYTES) != hipSuccess) { fprintf(stderr, "kernel_launch: hipFuncSetAttribute failed\n"); grid = -1; return; }
        if (hipOccupancyMaxActiveBlocksPerMultiprocessor(&per_cu, (const void*)fwd_kernel, 512, LDS_BYTES) != hipSuccess || per_cu < 1) { fprintf(stderr, "kernel_launch: occupancy query says %d\n", per_cu); (void)hipGetLastError(); per_cu = 1; }
        grid = cus;
    }
    if (grid < 0) return;
    (void)hipMemsetAsync((char*)d_ws + WS_CTL, 0, 64 * 1024, stream);
    Args a{};
    for (int i = 0; i < 26; ++i) a.in[i] = (const float*)d_in[i];
    a.out = (float*)d_out; a.ws = (unsigned char*)d_ws;
    if (N_LAUNCHES == 1) { a.ph_lo = 0; a.ph_hi = N_PHASES; hipLaunchKernelGGL(fwd_kernel, dim3(grid), dim3(512), LDS_BYTES, stream, a); }
    else { for (int p = 0; p < N_PHASES; ++p) { a.ph_lo = p; a.ph_hi = p + 1; hipLaunchKernelGGL(fwd_kernel, dim3(grid), dim3(512), LDS_BYTES, stream, a); } }
}
```
